# Optimizing an MI355X kernel written in HIP

```python
import math
import jax, jax.numpy as jnp
from jax import lax
import numpy as np

D_MODEL = 1024
BATCH = 8
SEQ = 2048
DEPTH = 1
DEC_BATCH = 128
DEC_SEQ = 8
PAST_LEN = 16384
PAGE_SIZE = 128

N_MEM = 256
MIX_WIDTH = 2 * D_MODEL
ML_WIDTH = D_MODEL
ML_HEADS = 4
ML_HEAD_DIM = ML_WIDTH // ML_HEADS
CONV_CH = D_MODEL // 2
CONV_K = 3
XA_WIDTH = D_MODEL // 2
XA_HEADS = 4
XA_HEAD_DIM = XA_WIDTH // XA_HEADS
CHUNK = 64
EPS = 1e-6
IN_SIZES = [ML_WIDTH] * 5 + [ML_HEADS, ML_HEADS] + [CONV_CH] * 4 + [XA_WIDTH] * 2
IN_COLS = sum(IN_SIZES)

kernel_name = "hybrid_mlstm_shortconv_memxattn_step"


def rms_norm(x, g):
    xf = x.astype(jnp.float32)
    r = lax.rsqrt(jnp.mean(xf * xf, axis=-1, keepdims=True) + EPS)
    return (xf * r).astype(x.dtype) * g


def split_in(p):
    idx = [int(c) for c in np.cumsum(IN_SIZES)[:-1]]
    return jnp.split(p, idx, axis=-1)


def mlstm_chunkwise(q, k, v, i_pre, logf, C0, n0, m0):
    out_dtype = q.dtype
    f32 = jnp.float32
    B, T, H, d = q.shape
    L = math.gcd(T, CHUNK)
    nc = T // L

    def to_chunks(a):
        a = a.astype(f32).reshape((B, nc, L) + a.shape[2:])
        return jnp.moveaxis(a, 1, 0)

    xs = tuple(to_chunks(a) for a in (q, k, v, i_pre, logf))
    causal = jnp.tril(jnp.ones((L, L), dtype=bool))

    def step(carry, inp):
        C, n, m = carry
        qb, kb, vb, ib, fb = inp
        F = jnp.moveaxis(jnp.cumsum(fb, axis=1), 1, 2)
        ig = jnp.moveaxis(ib, 1, 2)
        Dm = ig[:, :, None, :] + F[:, :, :, None] - F[:, :, None, :]
        Dm = jnp.where(causal, Dm, -jnp.inf)
        inter = m[:, :, None] + F
        m_t = jnp.maximum(inter, jnp.max(Dm, axis=-1))
        S = jnp.einsum('bthd,bshd->bhts', qb, kb) * jnp.exp(Dm - m_t[..., None])
        w_inter = jnp.exp(inter - m_t)
        num = (w_inter[..., None] * jnp.einsum('bthd,bhde->bhte', qb, C)
               + jnp.einsum('bhts,bshe->bhte', S, vb))
        den = w_inter * jnp.einsum('bthd,bhd->bht', qb, n) + jnp.sum(S, axis=-1)
        h = num / jnp.maximum(jnp.abs(den), jnp.exp(-m_t))[..., None]
        m_new = m_t[:, :, -1]
        F_L = F[:, :, -1]
        w_C = jnp.exp(m + F_L - m_new)
        w_s = jnp.exp(ig + F_L[..., None] - F - m_new[..., None])
        C_new = w_C[..., None, None] * C + jnp.einsum('bhs,bshd,bshe->bhde', w_s, kb, vb)
        n_new = w_C[..., None] * n + jnp.einsum('bhs,bshd->bhd', w_s, kb)
        return (C_new, n_new, m_new), jnp.moveaxis(h, 1, 2)

    (C, n, m), hs = lax.scan(step, (C0.astype(f32), n0.astype(f32), m0.astype(f32)), xs)
    h = jnp.moveaxis(hs, 0, 1).reshape(B, T, H, d)
    return (h.astype(out_dtype), C.astype(out_dtype), n.astype(out_dtype), m.astype(out_dtype))


def memory_kv(mem, g_mem, w_mem_kv):
    B = mem.shape[0]
    kv = rms_norm(mem, g_mem) @ w_mem_kv
    mk, mv = jnp.split(kv, 2, axis=-1)
    return (mk.reshape(B, N_MEM, XA_HEADS, XA_HEAD_DIM), mv.reshape(B, N_MEM, XA_HEADS, XA_HEAD_DIM))


def hybrid_layer(x, mem_k, mem_v, C0, n0, m0, conv0,
                 g_norm, w_in, b_if, g_head, conv_w, conv_b, w_out):
    B, T, _ = x.shape
    xn = rms_norm(x, g_norm)
    proj = xn @ w_in
    (q, k, v, o_pre, z_ml, i_pre, f_pre,
     b_g, c_g, xc, z_cv, q_x, z_x) = split_in(proj)

    heads = lambda a: a.reshape(B, T, ML_HEADS, ML_HEAD_DIM)
    i_pre = i_pre + b_if[:ML_HEADS]
    logf = jax.nn.log_sigmoid(f_pre + b_if[ML_HEADS:])
    h, C, n, m = mlstm_chunkwise(heads(q), heads(k) * (ML_HEAD_DIM ** -0.5), heads(v),
                                 i_pre, logf, C0, n0, m0)
    h = jax.nn.sigmoid(heads(o_pre)) * h
    h = rms_norm(h, g_head.reshape(ML_HEADS, ML_HEAD_DIM))
    y_ml = h.reshape(B, T, ML_WIDTH) * jax.nn.silu(z_ml)

    u = c_g * xc
    ext = jnp.concatenate([conv0.astype(u.dtype), u], axis=1)
    yc = conv_b + sum(conv_w[j] * ext[:, j:j + T] for j in range(CONV_K))
    y_cv = b_g * yc * jax.nn.silu(z_cv)
    conv_new = ext[:, T:]

    qx = q_x.reshape(B, T, XA_HEADS, XA_HEAD_DIM)
    s = jnp.einsum('bthd,bshd->bhts', qx, mem_k).astype(jnp.float32) * (XA_HEAD_DIM ** -0.5)
    p = jax.nn.softmax(s, axis=-1).astype(x.dtype)
    y_xa = jnp.einsum('bhts,bshd->bthd', p, mem_v).reshape(B, T, XA_WIDTH) * jax.nn.silu(z_x)

    y = jnp.concatenate([y_ml, y_cv, y_xa], axis=-1) @ w_out
    return (x + y, C, n, m, conv_new)


def setup_inputs(seed: int = 0) -> dict:
    key = jax.random.key(seed)
    ks = jax.random.split(key, 20)
    nrm = jax.random.normal
    f32 = jnp.float32
    x_prompt = nrm(ks[0], (BATCH, SEQ, D_MODEL), f32)
    x_sample = nrm(ks[1], (DEC_BATCH, DEC_SEQ, D_MODEL), f32)
    state_mlstm_C = 0.05 * nrm(ks[2], (DEPTH, DEC_BATCH, ML_HEADS, ML_HEAD_DIM, ML_HEAD_DIM), f32)
    state_mlstm_n = 0.5 * nrm(ks[3], (DEPTH, DEC_BATCH, ML_HEADS, ML_HEAD_DIM), f32)
    state_mlstm_m = jax.random.uniform(ks[4], (DEPTH, DEC_BATCH, ML_HEADS), f32, 0.0, 4.0)
    state_conv = 0.5 * nrm(ks[5], (DEPTH, DEC_BATCH, CONV_K - 1, CONV_CH), f32)
    cache_mem_k = nrm(ks[6], (DEPTH, DEC_BATCH, N_MEM, XA_HEADS, XA_HEAD_DIM), f32)
    cache_mem_v = nrm(ks[7], (DEPTH, DEC_BATCH, N_MEM, XA_HEADS, XA_HEAD_DIM), f32)
    mem_prompt = nrm(ks[8], (BATCH, N_MEM, D_MODEL), f32)
    g_norm = 1.0 + 0.05 * nrm(ks[9], (DEPTH, D_MODEL), f32)
    w_in = nrm(ks[10], (DEPTH, D_MODEL, IN_COLS), f32) * D_MODEL ** -0.5
    forget_bias = jnp.tile(jnp.linspace(3.0, 6.0, ML_HEADS, dtype=f32), (DEPTH, 1))
    b_if = jnp.concatenate([0.1 * nrm(ks[11], (DEPTH, ML_HEADS), f32),
                            forget_bias + 0.1 * nrm(ks[12], (DEPTH, ML_HEADS), f32)], axis=-1)
    g_head = 1.0 + 0.05 * nrm(ks[13], (DEPTH, ML_WIDTH), f32)
    conv_w = nrm(ks[14], (DEPTH, CONV_K, CONV_CH), f32) * CONV_K ** -0.5
    conv_b = 0.02 * nrm(ks[15], (DEPTH, CONV_CH), f32)
    g_mem = 1.0 + 0.05 * nrm(ks[16], (DEPTH, D_MODEL), f32)
    w_mem_kv = nrm(ks[17], (DEPTH, D_MODEL, 2 * XA_WIDTH), f32) * D_MODEL ** -0.5
    w_out = nrm(ks[18], (DEPTH, MIX_WIDTH, D_MODEL), f32) * MIX_WIDTH ** -0.5
    g_final = 1.0 + 0.05 * nrm(ks[19], (D_MODEL,), f32)
    return {"x_prompt": x_prompt, "x_sample": x_sample,
            "state_mlstm_C": state_mlstm_C, "state_mlstm_n": state_mlstm_n,
            "state_mlstm_m": state_mlstm_m, "state_conv": state_conv,
            "cache_mem_k": cache_mem_k, "cache_mem_v": cache_mem_v,
            "mem_prompt": mem_prompt,
            "g_norm": g_norm, "w_in": w_in, "b_if": b_if, "g_head": g_head,
            "conv_w": conv_w, "conv_b": conv_b, "g_mem": g_mem, "w_mem_kv": w_mem_kv,
            "w_out": w_out, "g_final": g_final}


def reference(x_prompt, x_sample, state_mlstm_C, state_mlstm_n, state_mlstm_m, state_conv,
              cache_mem_k, cache_mem_v, mem_prompt,
              g_norm, w_in, b_if, g_head, conv_w, conv_b, g_mem, w_mem_kv, w_out, g_final):
    Bp = x_prompt.shape[0]
    dt = x_prompt.dtype
    hp, hs = x_prompt, x_sample
    Cp_l, np_l, mp_l, cvp_l, mkp_l, mvp_l = [], [], [], [], [], []
    Cs_l, ns_l, ms_l, cvs_l = [], [], [], []
    for l in range(DEPTH):
        lw = (g_norm[l], w_in[l], b_if[l], g_head[l], conv_w[l], conv_b[l], w_out[l])
        mk_p, mv_p = memory_kv(mem_prompt, g_mem[l], w_mem_kv[l])
        C0 = jnp.zeros((Bp, ML_HEADS, ML_HEAD_DIM, ML_HEAD_DIM), dt)
        n0 = jnp.zeros((Bp, ML_HEADS, ML_HEAD_DIM), dt)
        m0 = jnp.zeros((Bp, ML_HEADS), dt)
        cv0 = jnp.zeros((Bp, CONV_K - 1, CONV_CH), dt)
        hp, Cp, np_, mp, cvp = hybrid_layer(hp, mk_p, mv_p, C0, n0, m0, cv0, *lw)
        hs, Cs, ns, ms, cvs = hybrid_layer(hs, cache_mem_k[l], cache_mem_v[l],
                                           state_mlstm_C[l], state_mlstm_n[l],
                                           state_mlstm_m[l], state_conv[l], *lw)
        Cp_l.append(Cp); np_l.append(np_); mp_l.append(mp); cvp_l.append(cvp)
        mkp_l.append(mk_p); mvp_l.append(mv_p)
        Cs_l.append(Cs); ns_l.append(ns); ms_l.append(ms); cvs_l.append(cvs)
    y_prompt = rms_norm(hp, g_final)
    y_sample = rms_norm(hs, g_final)
    return (y_prompt, y_sample,
            jnp.stack(Cp_l), jnp.stack(np_l), jnp.stack(mp_l), jnp.stack(cvp_l),
            jnp.stack(mkp_l), jnp.stack(mvp_l),
            jnp.stack(Cs_l), jnp.stack(ns_l), jnp.stack(ms_l), jnp.stack(cvs_l))
```

```cpp
#include <hip/hip_runtime.h>
#include <cstdio>
#include <cstdint>
namespace pg8 {
#define PG8_LAS __attribute__((address_space(3)))
typedef unsigned short bf16_t;
typedef short bf16x8 __attribute__((ext_vector_type(8)));
typedef float f32x4 __attribute__((ext_vector_type(4)));
typedef unsigned u32x4 __attribute__((ext_vector_type(4)));
constexpr int BM = 256, BK = 64, HALF = 128, HTB = HALF * BK * 2  , STAGE_BYTES = 8 * HTB, NXCD = 8, WGM = 8;

__host__ __device__ __forceinline__ int lds_byte(int r, int c) { const int st = (r >> 4) * 2 + (c >> 5), rr = r & 15, cc = c & 31, ob = rr * 64 + cc * 2; return st * 1024 + (ob ^ (((ob >> 9) & 1) << 5)); }
__host__ __device__ __forceinline__ void stage_rc(int b, int& R, int& C) { const int st = b / 1024, sb = b % 1024, swz = sb ^ (((sb >> 9) & 1) << 5); R = (st >> 1) * 16 + swz / 64; C = (st & 1) * 32 + (swz % 64) / 2; }
__host__ __device__ __forceinline__ int perm32(int rho) { const int n = rho >> 4, i = rho & 15; return 8 * (i >> 2) + 4 * n + (i & 3); }

struct Unit { int pm, pn; };
struct Gemm { const bf16_t* A; const bf16_t* Bt; int M, N, K; };

struct StaticOrder {
    int nM, nN, nwg, G, c;
    __host__ __device__ void init(int M, int N, int G_, int c_) { nM = M / BM; nN = N / BM; nwg = nM * nN; G = G_; c = c_; }
    __host__ __device__ bool next(int i, Unit& u) const {
        const long L = (long)i * G + c; if (L >= nwg) return false;
        int wgid = (int)L; { const int q = nwg / NXCD, r = nwg % NXCD, xcd = wgid % NXCD, off = wgid / NXCD; wgid = (xcd < r ? xcd * (q + 1) : r * (q + 1) + (xcd - r) * q) + off; }
        const int nig = WGM * nN, gid = wgid / nig, fm = gid * WGM, gsz = (nM - fm) < WGM ? (nM - fm) : WGM;
        u.pm = fm + ((wgid % nig) % gsz); u.pn = (wgid % nig) / gsz; return true;
    }
    __device__ __forceinline__ void a_ready(const Unit&) const {}
    __device__ __forceinline__ void done(const Unit&) const {}
};

__device__ __forceinline__ unsigned cvt_pk_bf16(float lo, float hi) { unsigned r; asm volatile("v_cvt_pk_bf16_f32 %0, %1, %2" : "=v"(r) : "v"(lo), "v"(hi)); return r; }
typedef float f32x2 __attribute__((ext_vector_type(2)));
struct EpiBf16Plain {
    static constexpr bool PERM = true, AFTER_DRAIN = false;
    bf16_t* O; int ldc;
    __device__ __forceinline__ void operator()(const f32x4 (&acc)[2][2][4][2], const Unit& u, int wr, int wc, int fr, int fq) const {
        const int row0 = u.pm * BM + wr * 64 + fr, col0 = u.pn * BM + wc * 32 + 8 * fq;
#pragma unroll
        for (int ai = 0; ai < 2; ++ai)
#pragma unroll
            for (int m = 0; m < 4; ++m) { bf16_t* rowp = O + (size_t)(row0 + ai * HALF + m * 16) * ldc + col0;
#pragma unroll
                for (int bj = 0; bj < 2; ++bj) { const f32x4 v0 = acc[ai][bj][m][0], v1 = acc[ai][bj][m][1];
                    u32x4 w; w.x = cvt_pk_bf16(v0[0], v0[1]); w.y = cvt_pk_bf16(v0[2], v0[3]); w.z = cvt_pk_bf16(v1[0], v1[1]); w.w = cvt_pk_bf16(v1[2], v1[3]);
                    *(u32x4*)(rowp + bj * HALF) = w; } }
    }
};
typedef unsigned u32x2e __attribute__((ext_vector_type(2)));
struct EpiKV {
    static constexpr bool PERM = false, AFTER_DRAIN = false;
    float* mk; float* mv; bf16_t* kb;
    __device__ __forceinline__ void operator()(const f32x4 (&acc)[2][2][4][2], const Unit& u, int wr, int wc, int fr, int fq) const {
        const int row0 = u.pm * BM + wr * 64 + fr, col0 = u.pn * BM + wc * 32 + 4 * fq;
        const bool isk = (u.pn < 2);
#pragma unroll
        for (int ai = 0; ai < 2; ++ai)
#pragma unroll
            for (int m = 0; m < 4; ++m) { const size_t r = (size_t)(row0 + ai * HALF + m * 16);
#pragma unroll
                for (int bj = 0; bj < 2; ++bj)
#pragma unroll
                    for (int n = 0; n < 2; ++n) { const int c = col0 + bj * HALF + n * 16; const f32x4 v = acc[ai][bj][m][n];
                        if (isk) { *(f32x4*)(mk + r * 512 + c) = v; u32x2e w; w.x = cvt_pk_bf16(v[0], v[1]); w.y = cvt_pk_bf16(v[2], v[3]); *(u32x2e*)(kb + r * 512 + c) = w; }
                        else     { *(f32x4*)(mv + r * 512 + (c - 512)) = v; } } }
    }
};
struct EpiOut {
    static constexpr bool PERM = false, AFTER_DRAIN = false;
    const float* xa; const float* xb; int split; float* out;
    __device__ __forceinline__ void operator()(const f32x4 (&acc)[2][2][4][2], const Unit& u, int wr, int wc, int fr, int fq) const {
        const int row0 = u.pm * BM + wr * 64 + fr, col0 = u.pn * BM + wc * 32 + 4 * fq;
        const float* xbase = (u.pm * BM < split) ? xa : (xb - (size_t)split * 1024);
#pragma unroll
        for (int ai = 0; ai < 2; ++ai)
#pragma unroll
            for (int m = 0; m < 4; ++m) { const size_t off = (size_t)(row0 + ai * HALF + m * 16) * 1024 + col0;
#pragma unroll
                for (int bj = 0; bj < 2; ++bj)
#pragma unroll
                    for (int n = 0; n < 2; ++n) { const f32x4 xv = *(const f32x4*)(xbase + off + bj * HALF + n * 16); *(f32x4*)(out + off + bj * HALF + n * 16) = xv + acc[ai][bj][m][n]; }
                if (m & 1) asm volatile("" ::: "memory"); }
    }
};

template <class Epi, class Sched, bool ALIGN_EPI = false, bool SP2 = false>
__device__ __forceinline__ void gemm_phase(PG8_LAS unsigned char* lds, const Gemm g, const Sched& S, const Epi& E) {
    const int tid = threadIdx.x, wid = __builtin_amdgcn_readfirstlane(tid >> 6), lane = tid & 63, wr = wid >> 2, wc = wid & 3, fr = lane & 15, fq = lane >> 4;
    const int K = g.K, nt = K / BK;
    unsigned voffA[2], voffB[2];
#pragma unroll
    for (int i = 0; i < 2; ++i) { int R, C; stage_rc(tid * 16 + i * 8192, R, C); const int Rb = Epi::PERM ? ((R & ~31) + perm32(R & 31)) : R;
        voffA[i] = (unsigned)(R * K + C) * 2u; voffB[i] = (unsigned)(Rb * K + C) * 2u; }
    const size_t kstep = (size_t)(BK * 2);
    const size_t hstep = (size_t)HALF * K * 2;
    const size_t tstep = 2 * hstep;
    const unsigned ldsw = (unsigned)wid * 1024u;
    const int aoff = lds_byte(wr * 64 + fr, fq * 8), boff = lds_byte(wc * 32 + fr, fq * 8);
#define PG8_SA(b, h) (((b) * 2 + (h)) * HTB)
#define PG8_SB(b, h) ((4 + (b) * 2 + (h)) * HTB)
#define PG8_STAGE(bufoff, gbase, voff) do { _Pragma("unroll") for (int _i = 0; _i < 2; ++_i) \
        __builtin_amdgcn_global_load_lds((const unsigned*)((const char*)(gbase) + (voff)[_i]), (PG8_LAS unsigned*)(lds + (bufoff) + ldsw + _i * 8192), 16, 0, 0); } while (0)
#define PG8_LDA(dst, b, h) do { _Pragma("unroll") for (int m = 0; m < 4; ++m) _Pragma("unroll") for (int k = 0; k < 2; ++k) dst[m][k] = *(const PG8_LAS bf16x8*)(lds + PG8_SA(b, h) + aoff + m * 2048 + k * 1024); } while (0)
#define PG8_LDB(dst, b, h) do { _Pragma("unroll") for (int n = 0; n < 2; ++n) _Pragma("unroll") for (int k = 0; k < 2; ++k) dst[n][k] = *(const PG8_LAS bf16x8*)(lds + PG8_SB(b, h) + boff + n * 2048 + k * 1024); } while (0)
#define PG8_MMA(ai, bj, At, Bt) do { __builtin_amdgcn_s_setprio(1); _Pragma("unroll") for (int m = 0; m < 4; ++m) _Pragma("unroll") for (int n = 0; n < 2; ++n) _Pragma("unroll") for (int k = 0; k < 2; ++k) \
        acc[ai][bj][m][n] = __builtin_amdgcn_mfma_f32_16x16x32_bf16(Bt[n][k], At[m][k], acc[ai][bj][m][n], 0, 0, 0); __builtin_amdgcn_s_setprio(0); } while (0)
#define PG8_WAIT_V(n) asm volatile("s_waitcnt vmcnt(" #n ")" ::: "memory")
#define PG8_WAIT_L(n) asm volatile("s_waitcnt lgkmcnt(" #n ")" ::: "memory")
#define PG8_BAR __builtin_amdgcn_s_barrier()
#define PG8_SCHED __builtin_amdgcn_sched_barrier(0)
    Unit cur, nxt; int ui = 0;
    if (!S.next(0, cur)) return;
    f32x4 acc[2][2][4][2];
#pragma unroll
    for (int a = 0; a < 2; ++a)
#pragma unroll
        for (int b = 0; b < 2; ++b)
#pragma unroll
            for (int m = 0; m < 4; ++m)
#pragma unroll
                for (int n = 0; n < 2; ++n) acc[a][b][m][n] = (f32x4){0.f, 0.f, 0.f, 0.f};
    bf16x8 At[4][2], B0[2][2], B1[2][2];
    const char* cA = (const char*)g.A + (size_t)cur.pm * tstep; const char* cB = (const char*)g.Bt + (size_t)cur.pn * tstep;
    S.a_ready(cur);
    if constexpr (SP2) {
        PG8_STAGE(PG8_SB(0, 0), cB, voffB); PG8_STAGE(PG8_SB(0, 1), cB + hstep, voffB); PG8_STAGE(PG8_SA(0, 0), cA, voffA); PG8_STAGE(PG8_SA(0, 1), cA + hstep, voffA);
        if (wr == 1) PG8_BAR;
        PG8_WAIT_V(2); PG8_BAR;
        PG8_STAGE(PG8_SB(1, 0), cB + kstep, voffB); PG8_STAGE(PG8_SA(1, 0), cA + kstep, voffA); PG8_STAGE(PG8_SB(1, 1), cB + hstep + kstep, voffB);
        PG8_WAIT_V(6); PG8_BAR;
    } else {
        PG8_STAGE(PG8_SB(0, 0), cB, voffB); PG8_STAGE(PG8_SA(0, 0), cA, voffA); PG8_STAGE(PG8_SB(0, 1), cB + hstep, voffB); PG8_STAGE(PG8_SA(0, 1), cA + hstep, voffA);
        if (wr == 1) PG8_BAR;
        PG8_WAIT_V(4); PG8_BAR;
        PG8_STAGE(PG8_SB(1, 0), cB + kstep, voffB); PG8_STAGE(PG8_SA(1, 0), cA + kstep, voffA); PG8_STAGE(PG8_SB(1, 1), cB + hstep + kstep, voffB);
        PG8_WAIT_V(6); PG8_BAR;
    }
    for (;;) {
        const bool has_next = S.next(ui + 1, nxt);
        const char* nA = has_next ? (const char*)g.A + (size_t)nxt.pm * tstep : cA; const char* nB = has_next ? (const char*)g.Bt + (size_t)nxt.pn * tstep : cB;
        for (int t = 0; t < nt; t += 2) {
            const bool last = (t == nt - 2);
            const char* a1 = cA + (size_t)(t + 1) * kstep;
            const char* a2 = last ? nA : cA + (size_t)(t + 2) * kstep; const char* b2 = last ? nB : cB + (size_t)(t + 2) * kstep;
            const char* a3 = a2 + kstep; const char* b3 = b2 + kstep;
            if (last && has_next) S.a_ready(nxt);
            if constexpr (SP2) {
            PG8_LDB(B0, 0, 0); PG8_LDB(B1, 0, 1); PG8_SCHED; PG8_LDA(At, 0, 0); PG8_STAGE(PG8_SA(1, 1), a1 + hstep, voffA);
            PG8_WAIT_V(8); PG8_WAIT_L(0); PG8_BAR; PG8_MMA(0, 0, At, B0); PG8_MMA(0, 1, At, B1); PG8_BAR; PG8_SCHED;
            PG8_LDA(At, 0, 1); PG8_STAGE(PG8_SB(0, 0), b2, voffB); PG8_STAGE(PG8_SB(0, 1), b2 + hstep, voffB); PG8_STAGE(PG8_SA(0, 0), a2, voffA);
            PG8_WAIT_V(8); PG8_WAIT_L(0); PG8_BAR; PG8_MMA(1, 0, At, B0); PG8_MMA(1, 1, At, B1); PG8_BAR; PG8_SCHED;
            PG8_LDB(B0, 1, 0); PG8_LDB(B1, 1, 1); PG8_SCHED; PG8_LDA(At, 1, 0); PG8_STAGE(PG8_SA(0, 1), a2 + hstep, voffA);
            PG8_WAIT_V(8); PG8_WAIT_L(0); PG8_BAR; PG8_MMA(0, 0, At, B0); PG8_MMA(0, 1, At, B1); PG8_BAR; PG8_SCHED;
            PG8_LDA(At, 1, 1); PG8_STAGE(PG8_SB(1, 0), b3, voffB); PG8_STAGE(PG8_SB(1, 1), b3 + hstep, voffB); PG8_STAGE(PG8_SA(1, 0), a3, voffA);
            PG8_WAIT_V(8); PG8_WAIT_L(0); PG8_BAR; PG8_MMA(1, 0, At, B0); PG8_MMA(1, 1, At, B1); PG8_BAR; PG8_SCHED;
            } else {
            PG8_LDB(B0, 0, 0); PG8_SCHED; PG8_LDA(At, 0, 0); PG8_STAGE(PG8_SA(1, 1), a1 + hstep, voffA);
            PG8_WAIT_L(8); PG8_BAR; PG8_WAIT_L(0); PG8_MMA(0, 0, At, B0); PG8_BAR; PG8_SCHED;
            PG8_LDB(B1, 0, 1); PG8_STAGE(PG8_SB(0, 0), b2, voffB);
            PG8_BAR; PG8_WAIT_L(0); PG8_MMA(0, 1, At, B1); PG8_BAR;
            PG8_LDA(At, 0, 1); PG8_STAGE(PG8_SA(0, 0), a2, voffA);
            PG8_BAR; PG8_WAIT_L(0); PG8_MMA(1, 0, At, B0); PG8_BAR; PG8_SCHED;
            PG8_STAGE(PG8_SB(0, 1), b2 + hstep, voffB);
            PG8_WAIT_V(6); PG8_BAR; PG8_MMA(1, 1, At, B1); PG8_BAR;
            PG8_LDB(B0, 1, 0); PG8_SCHED; PG8_LDA(At, 1, 0); PG8_STAGE(PG8_SA(0, 1), a2 + hstep, voffA);
            PG8_WAIT_L(8); PG8_BAR; PG8_WAIT_L(0); PG8_MMA(0, 0, At, B0); PG8_BAR; PG8_SCHED;
            PG8_LDB(B1, 1, 1); PG8_STAGE(PG8_SB(1, 0), b3, voffB);
            PG8_BAR; PG8_WAIT_L(0); PG8_MMA(0, 1, At, B1); PG8_BAR;
            PG8_LDA(At, 1, 1); PG8_STAGE(PG8_SA(1, 0), a3, voffA);
            PG8_BAR; PG8_WAIT_L(0); PG8_MMA(1, 0, At, B0); PG8_BAR; PG8_SCHED;
            PG8_STAGE(PG8_SB(1, 1), b3 + hstep, voffB);
            PG8_WAIT_V(6); PG8_BAR; PG8_MMA(1, 1, At, B1); PG8_BAR;
            }
        }
        if constexpr (ALIGN_EPI) { if (wr == 0) PG8_BAR; }
        if constexpr (!Epi::AFTER_DRAIN) { E(acc, cur, wr, wc, fr, fq); S.done(cur); }
        if (!has_next) break;
#pragma unroll
        for (int a = 0; a < 2; ++a)
#pragma unroll
            for (int b = 0; b < 2; ++b)
#pragma unroll
                for (int m = 0; m < 4; ++m)
#pragma unroll
                    for (int n = 0; n < 2; ++n) acc[a][b][m][n] = (f32x4){0.f, 0.f, 0.f, 0.f};
        cur = nxt; cA = nA; cB = nB; ++ui;
        if constexpr (ALIGN_EPI) { if (wr == 1) PG8_BAR; }
    }
    PG8_WAIT_V(0);
    if constexpr (!ALIGN_EPI) { if (wr == 0) PG8_BAR; }
    PG8_BAR;
    if constexpr (Epi::AFTER_DRAIN) { E.fused(acc, cur, wr, wc, fr, fq, lds, wid, lane); S.done(cur); }
#undef PG8_SA
#undef PG8_SB
#undef PG8_STAGE
#undef PG8_LDA
#undef PG8_LDB
#undef PG8_MMA
#undef PG8_WAIT_V
#undef PG8_WAIT_L
#undef PG8_BAR
#undef PG8_SCHED
}
}
#define GAS __attribute__((address_space(1)))
#define LAS __attribute__((address_space(3)))
typedef unsigned short bf16;
typedef unsigned v4u __attribute__((ext_vector_type(4)));
typedef float f32x4 __attribute__((ext_vector_type(4)));
typedef short bf16x8 __attribute__((ext_vector_type(8)));
typedef GAS unsigned gu32;
typedef GAS unsigned long long gu64;
#define RLX_AGENT __ATOMIC_RELAXED, __HIP_MEMORY_SCOPE_AGENT
#define LDS_WAIT() asm volatile("s_waitcnt lgkmcnt(0)" ::: "memory")
#define VM_WAIT() asm volatile("s_waitcnt vmcnt(0)" ::: "memory")
__device__ __forceinline__ unsigned long long rt() { return __builtin_amdgcn_s_memrealtime(); }
__device__ __forceinline__ unsigned f2bf(float f) { unsigned u = __builtin_bit_cast(unsigned, f); return (u + 0x7fffu + ((u >> 16) & 1u)) >> 16; }
__device__ __forceinline__ unsigned pk2(float lo, float hi) { return f2bf(lo) | (f2bf(hi) << 16); }

#define XB_TMO      128
#define XB_XCNT(j)  (256  + 64 * (j))
#define XB_XSUB(j)  (1280 + 64 * (j))
#define XB_XGEN(j)  (2304 + 64 * (j))
#define XB_TOP      3328
#define XB_TOPGEN   3392
#define XCD_BAR_WORDS 3456
#define XB_SPIN_CAP (1u << 18)

__device__ __forceinline__ unsigned xb_ld(unsigned* p)              { return __hip_atomic_load(p, __ATOMIC_RELAXED, __HIP_MEMORY_SCOPE_AGENT); }
__device__ __forceinline__ unsigned xb_add(unsigned* p, unsigned v) { return __hip_atomic_fetch_add(p, v, __ATOMIC_RELAXED, __HIP_MEMORY_SCOPE_AGENT); }
__device__ __forceinline__ unsigned xb_xcc_id() { return (unsigned)__builtin_amdgcn_s_getreg((3 << 11) | 20) & 0xFu; }
#define XB_SPIN(cond, bar) do { unsigned _sp = 0; while (cond) { __builtin_amdgcn_s_sleep(1); \
    if ((++_sp & 255u) == 0u) { if (xb_ld(&(bar)[XB_TMO])) break; if (_sp > XB_SPIN_CAP) { atomicAdd(&(bar)[XB_TMO], 1u); break; } } } } while (0)

struct XcdBarrier {
    unsigned* bar; unsigned x;
    volatile LAS unsigned* st;
};

__device__ __forceinline__ XcdBarrier xcd_barrier_post(unsigned* bar, volatile LAS unsigned* st) {
    XcdBarrier b; b.bar = bar; b.x = xb_xcc_id(); b.st = st;
    if (threadIdx.x == 0) (void)xb_add(&bar[XB_XCNT(b.x)], 1u);
    return b;
}
__device__ __forceinline__ void xcd_barrier_complete(unsigned* bar, unsigned x, unsigned& nloc, unsigned& nx) {
    const unsigned G = gridDim.x * gridDim.y * gridDim.z;
    unsigned sum, cnt, mine, sp = 0u;
    for (;;) {
        sum = 0u; cnt = 0u; mine = 0u;
#pragma unroll
        for (unsigned j = 0; j < 16; ++j) { const unsigned c = xb_ld(&bar[XB_XCNT(j)]); sum += c; cnt += (c > 0u) ? 1u : 0u; mine = (j == x) ? c : mine; }
        if (sum == G) break;
        __builtin_amdgcn_s_sleep(1);
        if ((++sp & 255u) == 0u) { if (xb_ld(&bar[XB_TMO])) break; if (sp > XB_SPIN_CAP) { atomicAdd(&bar[XB_TMO], 1u); break; } }
    }
    nloc = mine > 0u ? mine : 1u; nx = cnt > 0u ? cnt : 1u;
}

__device__ __forceinline__ void xcd_barrier(const XcdBarrier& b) {
    asm volatile("s_waitcnt vmcnt(0)" ::: "memory");
    __syncthreads();
    if (threadIdx.x == 0) {
        unsigned* bar = b.bar;
        __builtin_amdgcn_s_waitcnt(0);
        unsigned nloc = b.st[0], nx = b.st[1];
        if (nloc == 0u) { xcd_barrier_complete(bar, b.x, nloc, nx); b.st[0] = nloc; b.st[1] = nx; }
        const unsigned old = xb_add(&bar[XB_XSUB(b.x)], 1u);
        const unsigned gen = old / nloc;
        if (old + 1u == (gen + 1u) * nloc) {
            __builtin_amdgcn_fence(__ATOMIC_RELEASE, "agent");
            asm volatile("s_waitcnt vmcnt(0)" ::: "memory");
            const unsigned og = xb_add(&bar[XB_TOP], 1u);
            const unsigned tg = og / nx;
            if (og + 1u == (tg + 1u) * nx) xb_add(&bar[XB_TOPGEN], 1u);
            else XB_SPIN(xb_ld(&bar[XB_TOPGEN]) == tg, bar);
            __builtin_amdgcn_fence(__ATOMIC_ACQUIRE, "agent");
            xb_add(&bar[XB_XGEN(b.x)], 1u);
            asm volatile("s_waitcnt vmcnt(0)" ::: "memory");
        } else {
            XB_SPIN(xb_ld(&bar[XB_XGEN(b.x)]) == gen, bar);
            __builtin_amdgcn_fence(__ATOMIC_ACQUIRE, "agent");
            asm volatile("s_waitcnt vmcnt(0)" ::: "memory");
        }
    }
    __syncthreads();
}

#define DI __device__ __forceinline__
typedef float f32x16 __attribute__((ext_vector_type(16)));
typedef unsigned u32x2 __attribute__((ext_vector_type(2)));
typedef float f32x2v __attribute__((ext_vector_type(2)));
typedef __bf16 bf16x2_t __attribute__((ext_vector_type(2)));
#define MFMA32(a, b, c) __builtin_amdgcn_mfma_f32_32x32x16_bf16((a), (b), (c), 0, 0, 0)
#define MFMA16(a, b, c) __builtin_amdgcn_mfma_f32_16x16x32_bf16((a), (b), (c), 0, 0, 0)

DI unsigned cvtpk(float lo, float hi) { f32x2v v = {lo, hi}; bf16x2_t b = __builtin_convertvector(v, bf16x2_t); return __builtin_bit_cast(unsigned, b); }
DI float bf_lo(unsigned w) { return __uint_as_float(w << 16); }
DI float bf_hi(unsigned w) { return __uint_as_float(w & 0xffff0000u); }
DI float sigmoid_f(float x) { return __builtin_amdgcn_rcpf(1.f + __expf(-x)); }
DI float silu_f(float x) { return x * __builtin_amdgcn_rcpf(1.f + __expf(-x)); }
DI float wave_sum(float v) {
#pragma unroll
    for (int o = 1; o < 64; o <<= 1) v += __shfl_xor(v, o);
    return v;
}
DI float wave_max(float v) {
#pragma unroll
    for (int o = 1; o < 64; o <<= 1) v = fmaxf(v, __shfl_xor(v, o));
    return v;
}
DI int crow(int r, int hi) { return (r & 3) + 8 * (r >> 2) + 4 * hi; }
DI bf16x8 pack8(const f32x16& x, int s) {
    v4u p; p.x = cvtpk(x[8 * s + 0], x[8 * s + 1]); p.y = cvtpk(x[8 * s + 2], x[8 * s + 3]); p.z = cvtpk(x[8 * s + 4], x[8 * s + 5]); p.w = cvtpk(x[8 * s + 6], x[8 * s + 7]);
    return __builtin_bit_cast(bf16x8, p);
}

constexpr int DM = 1024, NB = 8, SEQ = 2048, MP = NB * SEQ, DB = 128, DS = 8, MS = DB * DS, MT = MP + MS;
constexpr int NPROJ = 8192, INCOLS = 8200, NMEMTOK = 256, MMEM = NB * NMEMTOK;
constexpr int PC_Q = 0, PC_K = 1024, PC_V = 2048, PC_O = 3072, PC_Z = 4096, PC_BG = 5120, PC_CG = 5632, PC_XC = 6144, PC_ZCV = 6656, PC_QX = 7168, PC_ZX = 7680;
constexpr int YC_ML = 0, YC_CV = 1024, YC_XA = 1536, NMIX = 2048;
constexpr float EPS = 1e-6f;
constexpr size_t O_YP = 0, O_YS = (size_t)MP * DM, O_CP = O_YS + (size_t)MS * DM, O_NP = O_CP + (size_t)NB * 4 * 65536, O_MP = O_NP + NB * 4 * 256, O_CVP = O_MP + NB * 4,
                 O_MK = O_CVP + NB * 2 * 512, O_MV = O_MK + (size_t)MMEM * 512, O_CS = O_MV + (size_t)MMEM * 512, O_NS = O_CS + (size_t)DB * 4 * 65536, O_MS = O_NS + DB * 4 * 256,
                 O_CVS = O_MS + DB * 4, O_END = O_CVS + DB * 2 * 512;
static_assert(O_END == 55853600, "d_out map");
constexpr size_t MiB = 1u << 20;
constexpr size_t WS_CTL = 0, CTL_ZERO_BYTES = 1 * MiB;
constexpr size_t WS_WIN = 2 * MiB, WS_WOUT = 18 * MiB, WS_WKV = 22 * MiB, WS_MEMN = 24 * MiB, WS_KMEM = 28 * MiB, WS_VT = 30 * MiB, WS_GATES = 32 * MiB, WS_XN = 34 * MiB, WS_YMIX = 68 * MiB,
                 WS_PROJ = 136 * MiB, WS_END = 408 * MiB;
static_assert(WS_XN + (size_t)MT * DM * 2 <= WS_YMIX && WS_YMIX + (size_t)MT * NMIX * 2 <= WS_PROJ && WS_PROJ + (size_t)MT * NPROJ * 2 <= WS_END, "d_ws map");
constexpr int CW_BAR = 4096, CW_QHEAD = 8192;
constexpr int LDS_BYTES = 147456, MISC_OFF = LDS_BYTES - 256;

DI void p0_transpose_item(const float* W, int ldw, int srccol, int k0, bf16* WT, int K, int dstrow, float scale, LAS float* scr, int lane) {
#pragma unroll 8
    for (int i = 0; i < 32; ++i) { const int kk = 2 * i + (lane >> 5); scr[kk * 33 + (lane & 31)] = W[(size_t)(k0 + kk) * ldw + srccol + (lane & 31)]; }
    LDS_WAIT(); asm volatile("" ::: "memory");
    const int c = lane & 7;
#pragma unroll
    for (int j = 0; j < 4; ++j) { const int n = (lane >> 3) + 8 * j; const LAS float* s = scr + (8 * c) * 33 + n;
        v4u o; o.x = pk2(s[0 * 33] * scale, s[1 * 33] * scale); o.y = pk2(s[2 * 33] * scale, s[3 * 33] * scale); o.z = pk2(s[4 * 33] * scale, s[5 * 33] * scale); o.w = pk2(s[6 * 33] * scale, s[7 * 33] * scale);
        *(GAS v4u*)(WT + (size_t)(dstrow + n) * K + k0 + 8 * c) = o; }
    LDS_WAIT(); asm volatile("" ::: "memory");
}
DI void xn_row(const float* xrow, const float* g, bf16* orow, float* gates_row, const LAS float* gw, const float* b_if, int lane) {
    const f32x4* xr = (const f32x4*)xrow + lane;
    f32x4 v[4]; float s = 0.f;
#pragma unroll
    for (int j = 0; j < 4; ++j) { v[j] = xr[64 * j]; s += (v[j].x * v[j].x + v[j].y * v[j].y) + (v[j].z * v[j].z + v[j].w * v[j].w); }
    const float r = rsqrtf(wave_sum(s) * (1.f / 1024.f) + EPS);
    if (gates_row) {
        float dot[8];
#pragma unroll
        for (int q = 0; q < 8; ++q) { float a = 0.f;
#pragma unroll
            for (int j = 0; j < 4; ++j) { const f32x4 w = *(const LAS f32x4*)(gw + q * 1024 + 256 * j + 4 * lane); a += (v[j].x * w.x + v[j].y * w.y) + (v[j].z * w.z + v[j].w * w.w); }
            dot[q] = wave_sum(a); }
        float mine = dot[0];
#pragma unroll
        for (int q = 1; q < 8; ++q) mine = (lane == q) ? dot[q] : mine;
        if (lane < 8) { float pre = mine * r + b_if[lane];
            if (lane >= 4) pre = (pre >= 0.f) ? -log1pf(expf(-pre)) : (pre - log1pf(expf(pre)));
            gates_row[lane] = pre; }
    }
    const f32x4* g4 = (const f32x4*)g + lane;
    u32x2* o8 = (u32x2*)orow + lane;
#pragma unroll
    for (int j = 0; j < 4; ++j) { const f32x4 gv = g4[64 * j]; u32x2 o; o.x = cvtpk(v[j].x * r * gv.x, v[j].y * r * gv.y); o.y = cvtpk(v[j].z * r * gv.z, v[j].w * r * gv.w); o8[64 * j] = o; }
}

constexpr int SC_Q = 0, SC_K = 33792, SC_SM = 67584, SC_KT = 75776, SC_VT = 108544, SC_MISC = 141312, QP = 528;
constexpr int SM_A = SC_MISC, SM_G = SC_MISC + 256, SM_WI = SC_MISC + 512, SM_WS = SC_MISC + 768, SM_HDMIN = SC_MISC + 1024, SM_RSP = SC_MISC + 1280, SM_QN = SC_MISC + 1792, SM_HINV = SC_MISC + 2048,
              SM_SCAL = SC_MISC + 2304, SM_N = SC_MISC + 2560;
static_assert(SM_N + 1024 <= MISC_OFF, "scan LDS map");
#define LF(off) (*(LAS float*)(lds + (off)))
#define OPAQUE(x) asm volatile("" : "+v"(x))
DI void scan_job(LAS unsigned char* lds, int bh, const bf16* PROJ, const float* GATES, const float* g_head, bf16* YMIX, float* outC, float* outN, float* outM, int tid0) {
    const int w = __builtin_amdgcn_readfirstlane(tid0 >> 6);
    const int b = bh >> 2, h = bh & 3;
    const size_t row_base = (size_t)b * SEQ;
    f32x16 Cacc[8];
#pragma unroll
    for (int i = 0; i < 8; ++i)
#pragma unroll
        for (int r = 0; r < 16; ++r) Cacc[i][r] = 0.f;
    float m_run = 0.f;
    if (tid0 < 256) LF(SM_N + tid0 * 4) = 0.f;
#pragma unroll 1
    for (int c = 0; c < SEQ / 64; ++c) {
        int tid = tid0; OPAQUE(tid);
        const int lane = tid & 63, hh = lane >> 5, l31 = lane & 31, l15 = lane & 15, lq = lane >> 4;
        const size_t r0 = row_base + (size_t)c * 64;
        { const int ch = tid & 31, rg = tid >> 5;
          v4u qv[4], kv[4], vv[4];
          const bf16* p0 = PROJ + (r0 + 4 * rg) * NPROJ + h * 256 + ch * 8;
#pragma unroll
          for (int i = 0; i < 4; ++i) { const bf16* p = p0 + (size_t)i * NPROJ; qv[i] = *(const v4u*)(p + PC_Q); kv[i] = *(const v4u*)(p + PC_K); vv[i] = *(const v4u*)(p + PC_V); }
          const int offq = (4 * rg) * QP + (ch >> 1) * 32 + (ch & 1) * 8;
#pragma unroll
          for (int i = 0; i < 4; ++i) { u32x2 a, bq; a.x = qv[i].x; a.y = qv[i].y; bq.x = qv[i].z; bq.y = qv[i].w;
              *(LAS u32x2*)(lds + SC_Q + offq + i * QP) = a; *(LAS u32x2*)(lds + SC_Q + offq + i * QP + 16) = bq;
              a.x = kv[i].x; a.y = kv[i].y; bq.x = kv[i].z; bq.y = kv[i].w;
              *(LAS u32x2*)(lds + SC_K + offq + i * QP) = a; *(LAS u32x2*)(lds + SC_K + offq + i * QP + 16) = bq; }
#pragma unroll
          for (int jj = 0; jj < 8; ++jj) { const int off = (8 * ch + jj) * 128 + ((((rg >> 1) ^ ((ch & 1) * 4 + (jj >> 1)))) << 4) + (rg & 1) * 8;
              unsigned k0 = kv[0][jj >> 1], k1 = kv[1][jj >> 1], k2 = kv[2][jj >> 1], k3 = kv[3][jj >> 1];
              unsigned v0 = vv[0][jj >> 1], v1 = vv[1][jj >> 1], v2 = vv[2][jj >> 1], v3 = vv[3][jj >> 1];
              u32x2 ko, vo;
              if (jj & 1) { ko.x = (k0 >> 16) | (k1 & 0xffff0000u); ko.y = (k2 >> 16) | (k3 & 0xffff0000u); vo.x = (v0 >> 16) | (v1 & 0xffff0000u); vo.y = (v2 >> 16) | (v3 & 0xffff0000u); }
              else        { ko.x = (k0 & 0xffffu) | (k1 << 16);     ko.y = (k2 & 0xffffu) | (k3 << 16);     vo.x = (v0 & 0xffffu) | (v1 << 16);     vo.y = (v2 & 0xffffu) | (v3 << 16); }
              *(LAS u32x2*)(lds + SC_KT + off) = ko; *(LAS u32x2*)(lds + SC_VT + off) = vo; }
        }
        if (w == 0) {
            const float gi = GATES[(r0 + lane) * 8 + h], gf = GATES[(r0 + lane) * 8 + 4 + h];
            float F = gf;
#pragma unroll
            for (int o = 1; o < 64; o <<= 1) { const float t = __shfl_up(F, o); if (lane >= o) F += t; }
            const float a = gi - F;
            float cm = a;
#pragma unroll
            for (int o = 1; o < 64; o <<= 1) { const float t = __shfl_up(cm, o); if (lane >= o) cm = fmaxf(cm, t); }
            const float g = fmaxf(m_run, cm);
            const float g63 = __shfl(g, 63), F63 = __shfl(F, 63);
            LF(SM_A + lane * 4) = a; LF(SM_G + lane * 4) = g; LF(SM_WI + lane * 4) = __expf(m_run - g); LF(SM_WS + lane * 4) = __expf(a - g63); LF(SM_HDMIN + lane * 4) = __expf(-(F + g));
            if (lane == 0) { LF(SM_SCAL) = __expf(m_run - g63); LF(SM_SCAL + 4) = F63 + g63; }
            m_run = F63 + g63;
        }
        __syncthreads();
        { const int rt = w >> 1, ct0 = (w & 1) * 2;
          f32x4 sacc[2]; sacc[0] = (f32x4){0.f, 0.f, 0.f, 0.f}; sacc[1] = sacc[0];
          const int abase = SC_Q + (16 * rt + l15) * QP + lq * 16, bbase = SC_K + (16 * ct0 + l15) * QP + lq * 16;
#pragma unroll
          for (int ks = 0; ks < 8; ++ks) { const bf16x8 af = *(const LAS bf16x8*)(lds + abase + ks * 64);
#pragma unroll
              for (int n = 0; n < 2; ++n) { const bf16x8 bf = *(const LAS bf16x8*)(lds + bbase + n * 16 * QP + ks * 64); sacc[n] = MFMA16(af, bf, sacc[n]); } }
          float gt[4], rs[4];
#pragma unroll
          for (int j = 0; j < 4; ++j) { gt[j] = LF(SM_G + (16 * rt + 4 * lq + j) * 4); rs[j] = 0.f; }
#pragma unroll
          for (int n = 0; n < 2; ++n) { const int s = 16 * (ct0 + n) + l15; const float as = LF(SM_A + s * 4);
#pragma unroll
              for (int j = 0; j < 4; ++j) { const int t = 16 * rt + 4 * lq + j; const float dcy = (s <= t) ? __expf(as - gt[j]) : 0.f; const float v = sacc[n][j] * dcy; rs[j] += v;
                  *(LAS unsigned short*)(lds + SC_SM + t * 128 + ((((s >> 3) ^ ((t >> 1) & 7))) << 4) + (s & 7) * 2) = (unsigned short)f2bf(v); } }
#pragma unroll
          for (int j = 0; j < 4; ++j) { float v = rs[j]; v += __shfl_xor(v, 1); v += __shfl_xor(v, 2); v += __shfl_xor(v, 4); v += __shfl_xor(v, 8);
              if (l15 == 0) LF(SM_RSP + ((w & 1) * 64 + 16 * rt + 4 * lq + j) * 4) = v; }
        }
        { const int t = tid >> 3, part = tid & 7; float acc = 0.f;
#pragma unroll
          for (int cc = 0; cc < 4; ++cc) { const int cx = 4 * part + cc; const v4u qv = *(const LAS v4u*)(lds + SC_Q + t * QP + cx * 16);
              const int d0 = 16 * (cx >> 1) + 4 * (cx & 1);
              const f32x4 n0 = *(const LAS f32x4*)(lds + SM_N + d0 * 4), n1 = *(const LAS f32x4*)(lds + SM_N + (d0 + 8) * 4);
              acc += bf_lo(qv.x) * n0.x + bf_hi(qv.x) * n0.y + bf_lo(qv.y) * n0.z + bf_hi(qv.y) * n0.w + bf_lo(qv.z) * n1.x + bf_hi(qv.z) * n1.y + bf_lo(qv.w) * n1.z + bf_hi(qv.w) * n1.w; }
          acc += __shfl_xor(acc, 1); acc += __shfl_xor(acc, 2); acc += __shfl_xor(acc, 4);
          if (part == 0) LF(SM_QN + t * 4) = acc;
        }
        __syncthreads();
        if (tid < 64) { const float rowsum = LF(SM_RSP + tid * 4) + LF(SM_RSP + 256 + tid * 4); const float den = LF(SM_WI + tid * 4) * LF(SM_QN + tid * 4) + rowsum;
            LF(SM_HINV + tid * 4) = 1.f / fmaxf(fabsf(den), LF(SM_HDMIN + tid * 4)); }
        f32x16 num[2];
#pragma unroll
        for (int r = 0; r < 16; ++r) { num[0][r] = 0.f; num[1][r] = 0.f; }
        { const int qb0 = SC_Q + l31 * QP + hh * 16;
#pragma unroll
          for (int i = 0; i < 8; ++i)
#pragma unroll
            for (int s2 = 0; s2 < 2; ++s2) { const bf16x8 bfr = pack8(Cacc[i], s2);
#pragma unroll
                for (int tt = 0; tt < 2; ++tt) { const bf16x8 afr = *(const LAS bf16x8*)(lds + qb0 + tt * 32 * QP + (4 * i + 2 * s2) * 16); num[tt] = MFMA32(afr, bfr, num[tt]); } } }
#pragma unroll
        for (int tt = 0; tt < 2; ++tt)
#pragma unroll
            for (int r = 0; r < 16; ++r) num[tt][r] *= LF(SM_WI + (32 * tt + crow(r, hh)) * 4);
        { const int sw = (l31 >> 1) & 7;
#pragma unroll
          for (int ks = 0; ks < 4; ++ks) { const int coff = (((2 * ks + hh) ^ sw) << 4);
            const bf16x8 bfr = *(const LAS bf16x8*)(lds + SC_VT + (32 * w + l31) * 128 + coff);
#pragma unroll
            for (int tt = 0; tt < 2; ++tt) { const bf16x8 afr = *(const LAS bf16x8*)(lds + SC_SM + (32 * tt + l31) * 128 + coff); num[tt] = MFMA32(afr, bfr, num[tt]); } } }
        __syncthreads();
        { const int e = 32 * w + l31;
#pragma unroll
          for (int tt = 0; tt < 2; ++tt)
#pragma unroll
            for (int r = 0; r < 16; ++r) { const int t = 32 * tt + crow(r, hh);
                LF(t * 1024 + ((((e >> 2) ^ ((r & 1) << 3))) << 4) + (e & 3) * 4) = num[tt][r] * LF(SM_HINV + t * 4); } }
        { const float wC = LF(SM_SCAL);
          const int sw = (l31 >> 1) & 7;
          bf16x8 bw[4];
#pragma unroll
          for (int ks = 0; ks < 4; ++ks) { const v4u vb = *(const LAS v4u*)(lds + SC_VT + (32 * w + l31) * 128 + (((2 * ks + hh) ^ sw) << 4));
              const f32x4 w0 = *(const LAS f32x4*)(lds + SM_WS + (16 * ks + 8 * hh) * 4), w1 = *(const LAS f32x4*)(lds + SM_WS + (16 * ks + 8 * hh) * 4 + 16);
              v4u o; o.x = cvtpk(bf_lo(vb.x) * w0.x, bf_hi(vb.x) * w0.y); o.y = cvtpk(bf_lo(vb.y) * w0.z, bf_hi(vb.y) * w0.w); o.z = cvtpk(bf_lo(vb.z) * w1.x, bf_hi(vb.z) * w1.y); o.w = cvtpk(bf_lo(vb.w) * w1.z, bf_hi(vb.w) * w1.w);
              bw[ks] = __builtin_bit_cast(bf16x8, o); }
#pragma unroll
          for (int i = 0; i < 8; ++i) {
#pragma unroll
              for (int r = 0; r < 16; ++r) Cacc[i][r] *= wC;
#pragma unroll
              for (int ks = 0; ks < 4; ++ks) { const bf16x8 afr = *(const LAS bf16x8*)(lds + SC_KT + i * 4096 + l31 * 128 + (((2 * ks + hh) ^ sw) << 4)); Cacc[i] = MFMA32(afr, bw[ks], Cacc[i]); } }
          if (tid < 256) { const int d = tid; float acc = 0.f;
#pragma unroll
              for (int cx = 0; cx < 8; ++cx) { const v4u kk = *(const LAS v4u*)(lds + SC_KT + d * 128 + ((cx ^ ((d >> 1) & 7)) << 4));
                  const f32x4 w0 = *(const LAS f32x4*)(lds + SM_WS + cx * 32), w1 = *(const LAS f32x4*)(lds + SM_WS + cx * 32 + 16);
                  acc += bf_lo(kk.x) * w0.x + bf_hi(kk.x) * w0.y + bf_lo(kk.y) * w0.z + bf_hi(kk.y) * w0.w + bf_lo(kk.z) * w1.x + bf_hi(kk.z) * w1.y + bf_lo(kk.w) * w1.z + bf_hi(kk.w) * w1.w; }
              LF(SM_N + d * 4) = wC * LF(SM_N + d * 4) + acc; }
        }
        __syncthreads();
        { const int t = tid >> 3, part = tid & 7; const size_t row = r0 + t;
          const bf16* po = PROJ + row * NPROJ + PC_O + h * 256 + 4 * part; const bf16* pz = PROJ + row * NPROJ + PC_Z + h * 256 + 4 * part;
          const int hb = t * 1024 + part * 16, tb = (t & 1);
          float ho[32]; float ssq = 0.f;
#pragma unroll
          for (int q = 0; q < 8; ++q) { const u32x2 ov = *(const u32x2*)(po + 32 * q);
              const f32x4 hv = *(const LAS f32x4*)(lds + hb + ((q ^ tb) << 7));
              ho[4 * q + 0] = sigmoid_f(bf_lo(ov.x)) * hv.x; ho[4 * q + 1] = sigmoid_f(bf_hi(ov.x)) * hv.y; ho[4 * q + 2] = sigmoid_f(bf_lo(ov.y)) * hv.z; ho[4 * q + 3] = sigmoid_f(bf_hi(ov.y)) * hv.w;
              ssq += (ho[4 * q] * ho[4 * q] + ho[4 * q + 1] * ho[4 * q + 1]) + (ho[4 * q + 2] * ho[4 * q + 2] + ho[4 * q + 3] * ho[4 * q + 3]); }
          ssq += __shfl_xor(ssq, 1); ssq += __shfl_xor(ssq, 2); ssq += __shfl_xor(ssq, 4);
          const float rr = rsqrtf(ssq * (1.f / 256.f) + EPS);
          const float* gp = g_head + h * 256 + 4 * part; bf16* yp = YMIX + row * NMIX + YC_ML + h * 256 + 4 * part;
#pragma unroll
          for (int q = 0; q < 8; ++q) { const u32x2 zv = *(const u32x2*)(pz + 32 * q); const f32x4 gh = *(const f32x4*)(gp + 32 * q);
              u32x2 o; o.x = cvtpk(ho[4 * q] * rr * gh.x * silu_f(bf_lo(zv.x)), ho[4 * q + 1] * rr * gh.y * silu_f(bf_hi(zv.x)));
              o.y = cvtpk(ho[4 * q + 2] * rr * gh.z * silu_f(bf_lo(zv.y)), ho[4 * q + 3] * rr * gh.w * silu_f(bf_hi(zv.y)));
              *(u32x2*)(yp + 32 * q) = o; }
        }
        __syncthreads();
    }
    { const int lane = tid0 & 63, hh = lane >> 5, l31 = lane & 31;
#pragma unroll
      for (int i = 0; i < 8; ++i)
#pragma unroll
        for (int r = 0; r < 16; ++r) outC[((size_t)bh * 256 + 32 * i + crow(r, hh)) * 256 + 32 * w + l31] = Cacc[i][r];
      if (tid0 < 256) outN[bh * 256 + tid0] = LF(SM_N + tid0 * 4);
      if (tid0 == 0) outM[bh] = m_run; }
    __syncthreads();
}

constexpr int AT_K = 0, AT_KP = 272, AT_VT = 69632, AT_VP = 520, AT_SUM = AT_VT + 128 * AT_VP;
static_assert(AT_SUM + 1024 <= MISC_OFF, "attention LDS map");
DI void attn_prompt_unit(LAS unsigned char* lds, int unit, const bf16* PROJ, const bf16* KMEM, const bf16* VT, bf16* YMIX, int tid) {
    const int lane = tid & 63, w = __builtin_amdgcn_readfirstlane(tid >> 6), hh = lane >> 5, l31 = lane & 31;
    const int b = unit >> 5, h = (unit >> 3) & 3, qb = unit & 7;
#pragma unroll
    for (int i = 0; i < 8; ++i) { const int idx = tid + 512 * i; const int key = idx >> 4, cx = idx & 15;
        const v4u v = *(const v4u*)(KMEM + (size_t)(b * 256 + key) * 512 + h * 128 + cx * 8); *(LAS v4u*)(lds + AT_K + key * AT_KP + cx * 16) = v; }
#pragma unroll
    for (int i = 0; i < 8; ++i) { const int idx = tid + 512 * i; const int d = idx >> 5, cx = idx & 31;
        const v4u v = *(const v4u*)(VT + (size_t)(h * 128 + d) * 2048 + b * 256 + cx * 8);
        u32x2 a, c; a.x = v.x; a.y = v.y; c.x = v.z; c.y = v.w;
        *(LAS u32x2*)(lds + AT_VT + d * AT_VP + cx * 16) = a; *(LAS u32x2*)(lds + AT_VT + d * AT_VP + cx * 16 + 8) = c; }
    __syncthreads();
    const size_t row0 = (size_t)b * SEQ + qb * 256 + 32 * w;
    const float c2 = 0.08838834764831845f * 1.4426950408889634f;
    float m_run = -3.0e38f, l_run = 0.f;
    f32x16 O[4];
#pragma unroll
    for (int dt = 0; dt < 4; ++dt)
#pragma unroll
        for (int r = 0; r < 16; ++r) O[dt][r] = 0.f;
    const bf16* qp = PROJ + (row0 + l31) * NPROJ + PC_QX + h * 128 + 8 * hh;
    const int kb0 = AT_K + l31 * AT_KP + hh * 16, vb0 = AT_VT + l31 * AT_VP + hh * 8;
#pragma unroll
    for (int half = 0; half < 2; ++half) {
        f32x16 acc[4];
#pragma unroll
        for (int kt = 0; kt < 4; ++kt)
#pragma unroll
            for (int r = 0; r < 16; ++r) acc[kt][r] = 0.f;
#pragma unroll
        for (int kh = 0; kh < 2; ++kh) {
            bf16x8 qf[4];
#pragma unroll
            for (int k4 = 0; k4 < 4; ++k4) qf[k4] = *(const bf16x8*)(qp + 16 * (4 * kh + k4));
#pragma unroll
            for (int k4 = 0; k4 < 4; ++k4)
#pragma unroll
                for (int kt = 0; kt < 4; ++kt) { const bf16x8 af = *(const LAS bf16x8*)(lds + kb0 + (4 * half + kt) * 32 * AT_KP + (4 * kh + k4) * 32); acc[kt] = MFMA32(af, qf[k4], acc[kt]); } }
        float mx = m_run;
#pragma unroll
        for (int kt = 0; kt < 4; ++kt)
#pragma unroll
            for (int r = 0; r < 16; ++r) mx = fmaxf(mx, acc[kt][r]);
        mx = fmaxf(mx, __shfl_xor(mx, 32));
        const float alpha = __builtin_amdgcn_exp2f((m_run - mx) * c2);
        m_run = mx;
        float sum = 0.f;
        bf16x8 pk[4][2];
#pragma unroll
        for (int kt = 0; kt < 4; ++kt) {
#pragma unroll
            for (int r = 0; r < 16; ++r) { const float p = __builtin_amdgcn_exp2f((acc[kt][r] - mx) * c2); acc[kt][r] = p; sum += p; }
            pk[kt][0] = pack8(acc[kt], 0); pk[kt][1] = pack8(acc[kt], 1); }
        sum += __shfl_xor(sum, 32);
        l_run = l_run * alpha + sum;
        if (half == 1) {
            __syncthreads();
            if (hh == 0) LF(AT_SUM + (w * 32 + l31) * 4) = alpha;
#pragma unroll
            for (int r = 0; r < 16; ++r) { const float al = LF(AT_SUM + (w * 32 + crow(r, hh)) * 4);
#pragma unroll
                for (int dt = 0; dt < 4; ++dt) O[dt][r] *= al; }
        }
#pragma unroll
        for (int kt = 0; kt < 4; ++kt)
#pragma unroll
            for (int s2 = 0; s2 < 2; ++s2)
#pragma unroll
                for (int dt = 0; dt < 4; ++dt) { const int o = vb0 + dt * 32 * AT_VP + (8 * (4 * half + kt) + 4 * s2) * 8;
                    const u32x2 lo = *(const LAS u32x2*)(lds + o), hi = *(const LAS u32x2*)(lds + o + 16);
                    v4u bv; bv.x = lo.x; bv.y = lo.y; bv.z = hi.x; bv.w = hi.y;
                    O[dt] = MFMA32(pk[kt][s2], __builtin_bit_cast(bf16x8, bv), O[dt]); }
    }
    asm volatile("s_waitcnt lgkmcnt(0)" ::: "memory");
    if (hh == 0) LF(AT_SUM + (w * 32 + l31) * 4) = l_run;
    { const int stg = AT_K + w * (32 * 264);
#pragma unroll
      for (int r = 0; r < 16; ++r) { const int q = crow(r, hh); const float inv = 1.f / LF(AT_SUM + (w * 32 + q) * 4);
#pragma unroll
        for (int dt = 0; dt < 4; ++dt) *(LAS unsigned short*)(lds + stg + q * 264 + (32 * dt + l31) * 2) = (unsigned short)f2bf(O[dt][r] * inv); }
#pragma unroll
      for (int i = 0; i < 8; ++i) { const int q = 4 * i + (lane >> 4), cx = lane & 15; const size_t row = row0 + q;
        const u32x2 oa = *(const LAS u32x2*)(lds + stg + q * 264 + cx * 16), ob = *(const LAS u32x2*)(lds + stg + q * 264 + cx * 16 + 8);
        const v4u zv = *(const v4u*)(PROJ + row * NPROJ + PC_ZX + h * 128 + cx * 8);
        v4u y; y.x = cvtpk(bf_lo(oa.x) * silu_f(bf_lo(zv.x)), bf_hi(oa.x) * silu_f(bf_hi(zv.x))); y.y = cvtpk(bf_lo(oa.y) * silu_f(bf_lo(zv.y)), bf_hi(oa.y) * silu_f(bf_hi(zv.y)));
        y.z = cvtpk(bf_lo(ob.x) * silu_f(bf_lo(zv.z)), bf_hi(ob.x) * silu_f(bf_hi(zv.z))); y.w = cvtpk(bf_lo(ob.y) * silu_f(bf_lo(zv.w)), bf_hi(ob.y) * silu_f(bf_hi(zv.w)));
        *(v4u*)(YMIX + row * NMIX + YC_XA + h * 128 + cx * 8) = y; } }
    __syncthreads();
}

constexpr int SS_QT = 0, SS_K = 8192, SS_V = 16384, SS_KWT = 24576, SS_QC = 32768;
DI void smlstm_unit(LAS unsigned char* lds, int bh, const bf16* PROJ, const float* GATES, const float* C0, const float* n0, const float* m0p, const float* g_head, bf16* YMIX,
                    float* outC, float* outN, float* outM, int tid) {
    const int lane = tid & 63, w = __builtin_amdgcn_readfirstlane(tid >> 6);
    const int b = bh >> 2, h = bh & 3;
    const size_t rowb = (size_t)MP + (size_t)b * 8;
    f32x4 q4, k4;
    { const bf16* p = PROJ + (rowb + w) * NPROJ + h * 256 + 4 * lane;
      const u32x2 qv = *(const u32x2*)(p + PC_Q), kv = *(const u32x2*)(p + PC_K), vv = *(const u32x2*)(p + PC_V);
      q4 = (f32x4){bf_lo(qv.x), bf_hi(qv.x), bf_lo(qv.y), bf_hi(qv.y)}; k4 = (f32x4){bf_lo(kv.x), bf_hi(kv.x), bf_lo(kv.y), bf_hi(kv.y)};
      const f32x4 v4 = (f32x4){bf_lo(vv.x), bf_hi(vv.x), bf_lo(vv.y), bf_hi(vv.y)};
      *(LAS f32x4*)(lds + SS_K + (w * 256 + 4 * lane) * 4) = k4; *(LAS f32x4*)(lds + SS_V + (w * 256 + 4 * lane) * 4) = v4;
#pragma unroll
      for (int i = 0; i < 4; ++i) LF(SS_QT + ((4 * lane + i) * 8 + w) * 4) = q4[i];
      *(LAS f32x4*)(lds + SS_QC + (w * 256 + 4 * lane) * 4) = (f32x4){0.f, 0.f, 0.f, 0.f}; }
    const float m0 = m0p[bh];
    float F[8], a[8], g[8], wsv[8];
    { float run = 0.f, cm = 0.f;
#pragma unroll
      for (int s = 0; s < 8; ++s) { const float gi = GATES[(rowb + s) * 8 + h], gf = GATES[(rowb + s) * 8 + 4 + h]; run += gf; F[s] = run; a[s] = gi - run; cm = (s == 0) ? a[0] : fmaxf(cm, a[s]); g[s] = fmaxf(m0, cm); } }
    const float g7 = g[7], wC = __expf(m0 - g7), m_new = F[7] + g7;
#pragma unroll
    for (int s = 0; s < 8; ++s) wsv[s] = __expf(a[s] - g7);
    float st[8], winter_t, hinv_t;
    { float gt = g[0], Ft = F[0], wsw = wsv[0];
#pragma unroll
      for (int s = 1; s < 8; ++s) { gt = (w == s) ? g[s] : gt; Ft = (w == s) ? F[s] : Ft; wsw = (w == s) ? wsv[s] : wsw; }
#pragma unroll
      for (int i = 0; i < 4; ++i) LF(SS_KWT + ((4 * lane + i) * 8 + w) * 4) = k4[i] * wsw;
      __syncthreads();
      float part[8];
#pragma unroll
      for (int s = 0; s < 8; ++s) { const f32x4 ks = *(const LAS f32x4*)(lds + SS_K + (s * 256 + 4 * lane) * 4); part[s] = wave_sum((q4.x * ks.x + q4.y * ks.y) + (q4.z * ks.z + q4.w * ks.w)); }
      const f32x4 n4 = *(const f32x4*)(n0 + (size_t)bh * 256 + 4 * lane);
      const float pn = wave_sum((q4.x * n4.x + q4.y * n4.y) + (q4.z * n4.z + q4.w * n4.w));
      float rowsum = 0.f;
#pragma unroll
      for (int s = 0; s < 8; ++s) { const float dcy = (s <= w) ? __expf(a[s] - gt) : 0.f; st[s] = part[s] * dcy; rowsum += st[s]; }
      winter_t = __expf(m0 - gt);
      const float den = winter_t * pn + rowsum;
      hinv_t = 1.f / fmaxf(fabsf(den), __expf(-(Ft + gt)));
    }
    f32x4 v4[8];
#pragma unroll
    for (int s = 0; s < 8; ++s) v4[s] = *(const LAS f32x4*)(lds + SS_V + (s * 256 + 4 * lane) * 4);
    f32x4 acc[8];
#pragma unroll
    for (int t = 0; t < 8; ++t) acc[t] = (f32x4){0.f, 0.f, 0.f, 0.f};
    const float* Cp = C0 + (size_t)bh * 65536 + 4 * lane; float* Co = outC + (size_t)bh * 65536 + 4 * lane;
#pragma unroll 4
    for (int r = 0; r < 32; ++r) { const int d = w + 8 * r;
        const f32x4 c4 = *(const f32x4*)(Cp + (size_t)d * 256);
        const f32x4 qa = *(const LAS f32x4*)(lds + SS_QT + d * 32), qb = *(const LAS f32x4*)(lds + SS_QT + d * 32 + 16);
        const f32x4 ka = *(const LAS f32x4*)(lds + SS_KWT + d * 32), kb = *(const LAS f32x4*)(lds + SS_KWT + d * 32 + 16);
        acc[0] += qa.x * c4; acc[1] += qa.y * c4; acc[2] += qa.z * c4; acc[3] += qa.w * c4; acc[4] += qb.x * c4; acc[5] += qb.y * c4; acc[6] += qb.z * c4; acc[7] += qb.w * c4;
        f32x4 cn = c4 * wC;
        cn += ka.x * v4[0]; cn += ka.y * v4[1]; cn += ka.z * v4[2]; cn += ka.w * v4[3]; cn += kb.x * v4[4]; cn += kb.y * v4[5]; cn += kb.z * v4[6]; cn += kb.w * v4[7];
        *(f32x4*)(Co + (size_t)d * 256) = cn; }
#pragma unroll
    for (int t = 0; t < 8; ++t)
#pragma unroll
        for (int i = 0; i < 4; ++i) __hip_atomic_fetch_add((LAS float*)(lds + SS_QC + (t * 256 + 4 * lane + i) * 4), acc[t][i], __ATOMIC_RELAXED, __HIP_MEMORY_SCOPE_WORKGROUP);
    if (tid < 256) { const int d = tid; const f32x4 ka = *(const LAS f32x4*)(lds + SS_KWT + d * 32), kb = *(const LAS f32x4*)(lds + SS_KWT + d * 32 + 16);
        outN[(size_t)bh * 256 + d] = wC * n0[(size_t)bh * 256 + d] + ((ka.x + ka.y) + (ka.z + ka.w)) + ((kb.x + kb.y) + (kb.z + kb.w)); }
    if (tid == 0) outM[bh] = m_new;
    __syncthreads();
    { const f32x4 qc = *(const LAS f32x4*)(lds + SS_QC + (w * 256 + 4 * lane) * 4);
      f32x4 num = qc * winter_t;
#pragma unroll
      for (int s = 0; s < 8; ++s) num += st[s] * v4[s];
      const f32x4 hv = num * hinv_t;
      const size_t row = rowb + w;
      const u32x2 ov = *(const u32x2*)(PROJ + row * NPROJ + PC_O + h * 256 + 4 * lane), zv = *(const u32x2*)(PROJ + row * NPROJ + PC_Z + h * 256 + 4 * lane);
      const f32x4 ho = (f32x4){sigmoid_f(bf_lo(ov.x)) * hv.x, sigmoid_f(bf_hi(ov.x)) * hv.y, sigmoid_f(bf_lo(ov.y)) * hv.z, sigmoid_f(bf_hi(ov.y)) * hv.w};
      const float ssq = wave_sum((ho.x * ho.x + ho.y * ho.y) + (ho.z * ho.z + ho.w * ho.w));
      const float rr = rsqrtf(ssq * (1.f / 256.f) + EPS);
      const f32x4 gh = *(const f32x4*)(g_head + h * 256 + 4 * lane);
      u32x2 o; o.x = cvtpk(ho.x * rr * gh.x * silu_f(bf_lo(zv.x)), ho.y * rr * gh.y * silu_f(bf_hi(zv.x))); o.y = cvtpk(ho.z * rr * gh.z * silu_f(bf_lo(zv.y)), ho.w * rr * gh.w * silu_f(bf_hi(zv.y)));
      *(u32x2*)(YMIX + row * NMIX + YC_ML + h * 256 + 4 * lane) = o; }
    __syncthreads();
}

constexpr int SA_Q = 0, SA_S = 4096, SA_K = 16384, SA_PART = 86016;
DI void sattn_unit(LAS unsigned char* lds, int bh, const bf16* PROJ, const float* ck, const float* cv, bf16* YMIX, int tid) {
    const int lane = tid & 63, w = __builtin_amdgcn_readfirstlane(tid >> 6);
    const int b = bh >> 2, h = bh & 3;
    const size_t rowb = (size_t)MP + (size_t)b * 8;
    if (tid < 256) { const int t = tid >> 5, d = (tid & 31) * 4; const u32x2 qv = *(const u32x2*)(PROJ + (rowb + t) * NPROJ + PC_QX + h * 128 + d);
        *(LAS f32x4*)(lds + SA_Q + (t * 128 + d) * 4) = (f32x4){bf_lo(qv.x), bf_hi(qv.x), bf_lo(qv.y), bf_hi(qv.y)}; }
#pragma unroll 1
    for (int half = 0; half < 2; ++half) {
#pragma unroll
        for (int i = 0; i < 8; ++i) { const int idx = tid + 512 * i; const int key = idx >> 5, c4 = idx & 31;
            const f32x4 v = *(const f32x4*)(ck + ((size_t)(b * 256 + half * 128 + key) * 4 + h) * 128 + c4 * 4); *(LAS f32x4*)(lds + SA_K + key * 528 + c4 * 16) = v; }
        __syncthreads();
        { const int key = tid & 127, tg = tid >> 7; float a0 = 0.f, a1 = 0.f;
#pragma unroll 8
          for (int c4 = 0; c4 < 32; ++c4) { const f32x4 kx = *(const LAS f32x4*)(lds + SA_K + key * 528 + c4 * 16);
              const f32x4 qa = *(const LAS f32x4*)(lds + SA_Q + ((2 * tg) * 128 + 4 * c4) * 4), qb = *(const LAS f32x4*)(lds + SA_Q + ((2 * tg + 1) * 128 + 4 * c4) * 4);
              a0 += (kx.x * qa.x + kx.y * qa.y) + (kx.z * qa.z + kx.w * qa.w); a1 += (kx.x * qb.x + kx.y * qb.y) + (kx.z * qb.z + kx.w * qb.w); }
          LF(SA_S + ((2 * tg) * 256 + half * 128 + key) * 4) = a0 * 0.08838834764831845f; LF(SA_S + ((2 * tg + 1) * 256 + half * 128 + key) * 4) = a1 * 0.08838834764831845f; }
        __syncthreads();
    }
    { f32x4 s4 = *(const LAS f32x4*)(lds + SA_S + (w * 256 + 4 * lane) * 4);
      const float mx = wave_max(fmaxf(fmaxf(s4.x, s4.y), fmaxf(s4.z, s4.w)));
      s4.x = __expf(s4.x - mx); s4.y = __expf(s4.y - mx); s4.z = __expf(s4.z - mx); s4.w = __expf(s4.w - mx);
      const float inv = 1.f / wave_sum((s4.x + s4.y) + (s4.z + s4.w));
      *(LAS f32x4*)(lds + SA_S + (w * 256 + 4 * lane) * 4) = s4 * inv; }
    __syncthreads();
    { const int d = tid & 127, kq = tid >> 7; float acc[8];
#pragma unroll
      for (int t = 0; t < 8; ++t) acc[t] = 0.f;
      const float* vp = cv + ((size_t)(b * 256 + kq * 64) * 4 + h) * 128 + d;
#pragma unroll 8
      for (int kk = 0; kk < 64; ++kk) { const float v = vp[(size_t)kk * 512]; const int key = kq * 64 + kk;
#pragma unroll
          for (int t = 0; t < 8; ++t) acc[t] += LF(SA_S + (t * 256 + key) * 4) * v; }
#pragma unroll
      for (int t = 0; t < 8; ++t) LF(SA_PART + ((kq * 8 + t) * 128 + d) * 4) = acc[t]; }
    __syncthreads();
    { const int t = tid >> 6, d = (tid & 63) * 2; float o0 = 0.f, o1 = 0.f;
#pragma unroll
      for (int kq = 0; kq < 4; ++kq) { const f32x2v p = *(const LAS f32x2v*)(lds + SA_PART + ((kq * 8 + t) * 128 + d) * 4); o0 += p.x; o1 += p.y; }
      const size_t row = rowb + t; const unsigned zv = *(const unsigned*)(PROJ + row * NPROJ + PC_ZX + h * 128 + d);
      *(unsigned*)(YMIX + row * NMIX + YC_XA + h * 128 + d) = cvtpk(o0 * silu_f(bf_lo(zv)), o1 * silu_f(bf_hi(zv))); }
    __syncthreads();
}

DI void conv_token(const bf16* p, const float (&w0)[8], const float (&w1)[8], const float (&w2)[8], const float (&cb)[8], float (&u2)[8], float (&u1)[8], float (&u)[8], bf16* yout) {
    const v4u bg = *(const v4u*)(p + PC_BG), cg = *(const v4u*)(p + PC_CG), xc = *(const v4u*)(p + PC_XC), zc = *(const v4u*)(p + PC_ZCV);
    float y[8];
#pragma unroll
    for (int i = 0; i < 4; ++i) {
        u[2 * i] = bf_lo(cg[i]) * bf_lo(xc[i]); u[2 * i + 1] = bf_hi(cg[i]) * bf_hi(xc[i]);
        const float yc0 = cb[2 * i] + w0[2 * i] * u2[2 * i] + w1[2 * i] * u1[2 * i] + w2[2 * i] * u[2 * i];
        const float yc1 = cb[2 * i + 1] + w0[2 * i + 1] * u2[2 * i + 1] + w1[2 * i + 1] * u1[2 * i + 1] + w2[2 * i + 1] * u[2 * i + 1];
        y[2 * i] = bf_lo(bg[i]) * yc0 * silu_f(bf_lo(zc[i])); y[2 * i + 1] = bf_hi(bg[i]) * yc1 * silu_f(bf_hi(zc[i])); }
    v4u o; o.x = cvtpk(y[0], y[1]); o.y = cvtpk(y[2], y[3]); o.z = cvtpk(y[4], y[5]); o.w = cvtpk(y[6], y[7]);
    *(v4u*)yout = o;
}
DI void conv_item(int item, const bf16* PROJ, const float* state_conv, const float* conv_w, const float* conv_b, bf16* YMIX, float* out_cvp, float* out_cvs, int tid) {
    const int c8 = tid & 63, sub = tid >> 6, ch = 8 * c8;
    float w0[8], w1[8], w2[8], cb[8], u2[8], u1[8], u[8];
#pragma unroll
    for (int i = 0; i < 8; ++i) { w0[i] = conv_w[ch + i]; w1[i] = conv_w[512 + ch + i]; w2[i] = conv_w[1024 + ch + i]; cb[i] = conv_b[ch + i]; }
    if (item < 64) {
        const int b = item >> 3, blk = item & 7, t0 = blk * 256 + sub * 32; const size_t rowb = (size_t)b * SEQ;
#pragma unroll
        for (int i = 0; i < 8; ++i) { u2[i] = 0.f; u1[i] = 0.f; }
        if (t0 >= 2) {
            const bf16* pa = PROJ + (rowb + t0 - 2) * NPROJ + ch; const bf16* pb = PROJ + (rowb + t0 - 1) * NPROJ + ch;
            const v4u cga = *(const v4u*)(pa + PC_CG), xca = *(const v4u*)(pa + PC_XC), cgb = *(const v4u*)(pb + PC_CG), xcb = *(const v4u*)(pb + PC_XC);
#pragma unroll
            for (int i = 0; i < 4; ++i) { u2[2 * i] = bf_lo(cga[i]) * bf_lo(xca[i]); u2[2 * i + 1] = bf_hi(cga[i]) * bf_hi(xca[i]); u1[2 * i] = bf_lo(cgb[i]) * bf_lo(xcb[i]); u1[2 * i + 1] = bf_hi(cgb[i]) * bf_hi(xcb[i]); }
        }
#pragma unroll 2
        for (int tt = 0; tt < 32; ++tt) { const int t = t0 + tt; const size_t row = rowb + t;
            conv_token(PROJ + row * NPROJ + ch, w0, w1, w2, cb, u2, u1, u, YMIX + row * NMIX + YC_CV + ch);
            if (t >= SEQ - 2) { float* o = out_cvp + ((size_t)b * 2 + (t - (SEQ - 2))) * 512 + ch; *(f32x4*)o = (f32x4){u[0], u[1], u[2], u[3]}; *(f32x4*)(o + 4) = (f32x4){u[4], u[5], u[6], u[7]}; }
#pragma unroll
            for (int i = 0; i < 8; ++i) { u2[i] = u1[i]; u1[i] = u[i]; } }
    } else {
        const int si = item - 64;
#pragma unroll 1
        for (int q = 0; q < 4; ++q) { const int seq = si * 32 + sub * 4 + q; const size_t rowb = (size_t)MP + (size_t)seq * 8;
#pragma unroll
            for (int i = 0; i < 8; ++i) { u2[i] = state_conv[((size_t)seq * 2 + 0) * 512 + ch + i]; u1[i] = state_conv[((size_t)seq * 2 + 1) * 512 + ch + i]; }
#pragma unroll 2
            for (int t = 0; t < 8; ++t) { const size_t row = rowb + t;
                conv_token(PROJ + row * NPROJ + ch, w0, w1, w2, cb, u2, u1, u, YMIX + row * NMIX + YC_CV + ch);
                if (t >= 6) { float* o = out_cvs + ((size_t)seq * 2 + (t - 6)) * 512 + ch; *(f32x4*)o = (f32x4){u[0], u[1], u[2], u[3]}; *(f32x4*)(o + 4) = (f32x4){u[4], u[5], u[6], u[7]}; }
#pragma unroll
                for (int i = 0; i < 8; ++i) { u2[i] = u1[i]; u1[i] = u[i]; } } }
    }
}
constexpr int IT_SM = 0, IT_SA = 512, IT_SC = 1024, IT_PA = 1028, IT_PC = 1284, NITEMS = 1348;

#ifndef PH_MASK
#define PH_MASK 511
#endif
#ifndef MK_N_LAUNCHES
#define MK_N_LAUNCHES 1
#endif
constexpr int N_PHASES = 5;
struct Args { const float* in[19]; float* out; unsigned char* ws; int ph_lo, ph_hi; };
__global__ void __launch_bounds__(512, 2) hyb_fwd(Args args) {
    extern __shared__ __attribute__((aligned(16))) unsigned char lds_raw[];
    LAS unsigned char* lds = (LAS unsigned char*)lds_raw;
    volatile LAS unsigned* MISC = (volatile LAS unsigned*)(lds + MISC_OFF);
    const int tid = threadIdx.x, lane = tid & 63, wave = __builtin_amdgcn_readfirstlane(tid >> 6);
    const int bid = blockIdx.x, G = gridDim.x;
    unsigned char* const ws = args.ws;
    gu32* const ctl = (gu32*)(ws + WS_CTL);
#define xp ((const float*)args.in[0])
#define xs ((const float*)args.in[1])
#define st_C ((const float*)args.in[2])
#define st_n ((const float*)args.in[3])
#define st_m ((const float*)args.in[4])
#define st_conv ((const float*)args.in[5])
#define ck ((const float*)args.in[6])
#define cv ((const float*)args.in[7])
#define memp ((const float*)args.in[8])
#define g_norm ((const float*)args.in[9])
#define w_in ((const float*)args.in[10])
#define b_if ((const float*)args.in[11])
#define g_head ((const float*)args.in[12])
#define conv_w ((const float*)args.in[13])
#define conv_b ((const float*)args.in[14])
#define g_mem ((const float*)args.in[15])
#define w_kv ((const float*)args.in[16])
#define w_out ((const float*)args.in[17])
#define g_final ((const float*)args.in[18])
#define out (args.out)
#define Wt_in ((bf16*)(ws + WS_WIN))
#define Wt_out ((bf16*)(ws + WS_WOUT))
#define Wt_kv ((bf16*)(ws + WS_WKV))
#define MEMN ((bf16*)(ws + WS_MEMN))
#define KMEM ((bf16*)(ws + WS_KMEM))
#define VT ((bf16*)(ws + WS_VT))
#define GATES ((float*)(ws + WS_GATES))
#define XN ((bf16*)(ws + WS_XN))
#define YMIX ((bf16*)(ws + WS_YMIX))
#define PROJ ((bf16*)(ws + WS_PROJ))
    if (tid < 64) MISC[tid] = 0u;
    __syncthreads();
    XcdBarrier bar; bar.bar = (unsigned*)(ctl + CW_BAR); bar.x = 0; bar.st = nullptr;
    if (MK_N_LAUNCHES == 1) bar = xcd_barrier_post((unsigned*)(ctl + CW_BAR), MISC + 8);
    const int lo = args.ph_lo, hi = args.ph_hi;
#define IN(k) (lo <= (k) && (k) < hi)
#define BOTH(k) (IN(k) && IN((k) + 1))
    const int gw = bid * 8 + wave, NGW = G * 8;

    if ((PH_MASK & 1) && IN(0)) {
        LAS float* scr = (LAS float*)(lds + wave * 16384);
        constexpr int I_IN = 16 * 256, I_OUT = 32 * 32, I_KV = 16 * 32, NIT = I_IN + I_OUT + I_KV;
        for (int it = gw; it < NIT; it += NGW) {
            int r = it;
            if (r < I_IN) { const int kb = r >> 8, nb = r & 255, dstrow = 32 * nb; const int srccol = dstrow + (dstrow >= 5120 ? 8 : 0); const float sc = (dstrow >= 1024 && dstrow < 2048) ? 0.0625f : 1.f;
                p0_transpose_item(w_in, INCOLS, srccol, 64 * kb, Wt_in, 1024, dstrow, sc, scr, lane); continue; }
            r -= I_IN;
            if (r < I_OUT) { const int kb = r >> 5, nb = r & 31; p0_transpose_item(w_out, 1024, 32 * nb, 64 * kb, Wt_out, 2048, 32 * nb, 1.f, scr, lane); continue; }
            r -= I_OUT;
            { const int kb = r >> 5, nb = r & 31; p0_transpose_item(w_kv, 1024, 32 * nb, 64 * kb, Wt_kv, 1024, 32 * nb, 1.f, scr, lane); }
        }
        __syncthreads();
        LAS float* gwl = (LAS float*)lds;
        for (int e = tid; e < 8192; e += 512) { const int q = e >> 10, k = e & 1023; gwl[e] = g_norm[k] * w_in[(size_t)k * INCOLS + 5120 + q]; }
        __syncthreads();
        for (int m = gw; m < MT; m += NGW) { const float* xrow = (m < MP) ? xp + (size_t)m * DM : xs + (size_t)(m - MP) * DM; xn_row(xrow, g_norm, XN + (size_t)m * DM, GATES + (size_t)m * 8, gwl, b_if, lane); }
        for (int m = gw; m < MMEM; m += NGW) xn_row(memp + (size_t)m * DM, g_mem, MEMN + (size_t)m * DM, nullptr, gwl, b_if, lane);
        if (BOTH(0)) xcd_barrier(bar);
    }
    if ((PH_MASK & 2) && IN(1)) {
        { pg8::Gemm g{XN, Wt_in, MT, NPROJ, DM}; pg8::StaticOrder S; S.init(MT, NPROJ, G, bid); pg8::EpiBf16Plain E{PROJ, NPROJ};
          pg8::gemm_phase<pg8::EpiBf16Plain, pg8::StaticOrder, true, true>(lds, g, S, E); }
        if (bid >= 128 && bid < 160) { pg8::Gemm g{MEMN, Wt_kv, MMEM, 1024, DM}; pg8::StaticOrder S; S.init(MMEM, 1024, 32, bid - 128); pg8::EpiKV E{out + O_MK, out + O_MV, KMEM};
          pg8::gemm_phase<pg8::EpiKV, pg8::StaticOrder, true, true>(lds, g, S, E); }
        if (bid >= 160 && bid < 176) { pg8::Gemm g{Wt_kv + (size_t)512 * DM, MEMN, 512, MMEM, DM}; pg8::StaticOrder S; S.init(512, MMEM, 16, bid - 160); pg8::EpiBf16Plain E{VT, MMEM};
          pg8::gemm_phase<pg8::EpiBf16Plain, pg8::StaticOrder, true, true>(lds, g, S, E); }
        if (BOTH(1)) xcd_barrier(bar);
    }
    if (IN(2)) {
        __syncthreads();
        if ((PH_MASK & 4) && bid < 32) scan_job(lds, bid, PROJ, GATES, g_head, YMIX, out + O_CP, out + O_NP, out + O_MP, tid);
        for (;;) {
            if (tid == 0) MISC[4] = __hip_atomic_fetch_add(ctl + CW_QHEAD, 1u, RLX_AGENT);
            __syncthreads();
            const int it = (int)MISC[4];
            __syncthreads();
            if (it >= NITEMS) break;
            int tid = threadIdx.x; OPAQUE(tid);
            if (it < IT_SA) { if (PH_MASK & 8) smlstm_unit(lds, it - IT_SM, PROJ, GATES, st_C, st_n, st_m, g_head, YMIX, out + O_CS, out + O_NS, out + O_MS, tid); }
            else if (it < IT_SC) { if (PH_MASK & 16) sattn_unit(lds, it - IT_SA, PROJ, ck, cv, YMIX, tid); }
            else if (it < IT_PA) { if (PH_MASK & 32) conv_item(64 + (it - IT_SC), PROJ, st_conv, conv_w, conv_b, YMIX, out + O_CVP, out + O_CVS, tid); }
            else if (it < IT_PC) { if (PH_MASK & 64) attn_prompt_unit(lds, it - IT_PA, PROJ, KMEM, VT, YMIX, tid); }
            else { if (PH_MASK & 32) conv_item(it - IT_PC, PROJ, st_conv, conv_w, conv_b, YMIX, out + O_CVP, out + O_CVS, tid); }
        }
        if (BOTH(2)) xcd_barrier(bar);
    }
    if ((PH_MASK & 128) && IN(3)) {
        __syncthreads();
        pg8::Gemm g{YMIX, Wt_out, MT, DM, NMIX}; pg8::StaticOrder S; S.init(MT, DM, G, bid); pg8::EpiOut E{xp, xs, MP, out + O_YP};
        pg8::gemm_phase<pg8::EpiOut, pg8::StaticOrder, true, true>(lds, g, S, E);
        if (BOTH(3)) xcd_barrier(bar);
    }
    if ((PH_MASK & 256) && IN(4)) {
        for (int m = gw; m < MT; m += NGW) { f32x4* row = (f32x4*)(out + O_YP + (size_t)m * DM) + lane; f32x4 v[4]; float s = 0.f;
#pragma unroll
            for (int j = 0; j < 4; ++j) { v[j] = row[64 * j]; s += (v[j].x * v[j].x + v[j].y * v[j].y) + (v[j].z * v[j].z + v[j].w * v[j].w); }
            const float r = rsqrtf(wave_sum(s) * (1.f / 1024.f) + EPS);
#pragma unroll
            for (int j = 0; j < 4; ++j) { const f32x4 gv = ((const f32x4*)g_final)[64 * j + lane]; row[64 * j] = v[j] * r * gv; } }
    }
#undef IN
#undef BOTH
}
#undef xp
#undef xs
#undef st_C
#undef st_n
#undef st_m
#undef st_conv
#undef ck
#undef cv
#undef memp
#undef g_norm
#undef w_in
#undef b_if
#undef g_head
#undef conv_w
#undef conv_b
#undef g_mem
#undef w_kv
#undef w_out
#undef g_final
#undef out
#undef Wt_in
#undef Wt_out
#undef Wt_kv
#undef MEMN
#undef KMEM
#undef VT
#undef GATES
#undef XN
#undef YMIX
#undef PROJ

extern "C" void kernel_launch(void* const* d_in, const int* in_sizes, int n_in, void* d_out, int out_size, void* d_ws, size_t ws_size, hipStream_t stream) {
    static int grid = 0;
    if (grid == 0) {
        if (n_in != 19 || (size_t)out_size != O_END || ws_size < WS_END) { fprintf(stderr, "kernel_launch: unexpected shapes (n_in %d, out %d, ws %zu); nothing launched\n", n_in, out_size, ws_size); grid = -1; return; }
        int dev = 0, cus = 0;
        if (hipGetDevice(&dev) != hipSuccess || hipDeviceGetAttribute(&cus, hipDeviceAttributeMultiprocessorCount, dev) != hipSuccess) { grid = -1; return; }
        if (hipFuncSetAttribute((const void*)hyb_fwd, hipFuncAttributeMaxDynamicSharedMemorySize, LDS_BYTES) != hipSuccess) { fprintf(stderr, "kernel_launch: hipFuncSetAttribute failed\n"); grid = -1; return; }
        (void)hipGetLastError();
        grid = cus;
        if (grid != 256) fprintf(stderr, "kernel_launch: %d CUs; this build's phase maps assume 256\n", grid);
    }
    if (grid < 0) return;
    if (hipMemsetAsync((char*)d_ws + WS_CTL, 0, CTL_ZERO_BYTES, stream) != hipSuccess) return;
    Args a{};
    for (int i = 0; i < 19; ++i) a.in[i] = (const float*)d_in[i];
    a.out = (float*)d_out; a.ws = (unsigned char*)d_ws;
    if (MK_N_LAUNCHES == 1) { a.ph_lo = 0; a.ph_hi = N_PHASES; hipLaunchKernelGGL(hyb_fwd, dim3(grid), dim3(512), LDS_BYTES, stream, a); }
    else for (int p = 0; p < N_PHASES; ++p) { a.ph_lo = p; a.ph_hi = p + 1; hipLaunchKernelGGL(hyb_fwd, dim3(grid), dim3(512), LDS_BYTES, stream, a); }
}
```

```cpp
#include <hip/hip_runtime.h>
#include <cstdio>
#include <cstdint>
namespace pg8 {
#define PG8_LAS __attribute__((address_space(3)))
typedef unsigned short bf16_t;
typedef short bf16x8 __attribute__((ext_vector_type(8)));
typedef float f32x4 __attribute__((ext_vector_type(4)));
typedef unsigned u32x4 __attribute__((ext_vector_type(4)));
constexpr int BM = 256, BK = 64, HALF = 128, HTB = HALF * BK * 2  , STAGE_BYTES = 8 * HTB, NXCD = 8, WGM = 8;

__host__ __device__ __forceinline__ int lds_byte(int r, int c) { const int st = (r >> 4) * 2 + (c >> 5), rr = r & 15, cc = c & 31, ob = rr * 64 + cc * 2; return st * 1024 + (ob ^ (((ob >> 9) & 1) << 5)); }
__host__ __device__ __forceinline__ void stage_rc(int b, int& R, int& C) { const int st = b / 1024, sb = b % 1024, swz = sb ^ (((sb >> 9) & 1) << 5); R = (st >> 1) * 16 + swz / 64; C = (st & 1) * 32 + (swz % 64) / 2; }
__host__ __device__ __forceinline__ int perm32(int rho) { const int n = rho >> 4, i = rho & 15; return 8 * (i >> 2) + 4 * n + (i & 3); }

struct Unit { int pm, pn; };
struct Gemm { const bf16_t* A; const bf16_t* Bt; int M, N, K; };

struct StaticOrder {
    int nM, nN, nwg, G, c;
    __host__ __device__ void init(int M, int N, int G_, int c_) { nM = M / BM; nN = N / BM; nwg = nM * nN; G = G_; c = c_; }
    __host__ __device__ bool next(int i, Unit& u) const {
        const long L = (long)i * G + c; if (L >= nwg) return false;
        int wgid = (int)L; { const int q = nwg / NXCD, r = nwg % NXCD, xcd = wgid % NXCD, off = wgid / NXCD; wgid = (xcd < r ? xcd * (q + 1) : r * (q + 1) + (xcd - r) * q) + off; }
        const int nig = WGM * nN, gid = wgid / nig, fm = gid * WGM, gsz = (nM - fm) < WGM ? (nM - fm) : WGM;
        u.pm = fm + ((wgid % nig) % gsz); u.pn = (wgid % nig) / gsz; return true;
    }
    __device__ __forceinline__ void a_ready(const Unit&) const {}
    __device__ __forceinline__ void done(const Unit&) const {}
};

__device__ __forceinline__ unsigned cvt_pk_bf16(float lo, float hi) { unsigned r; asm volatile("v_cvt_pk_bf16_f32 %0, %1, %2" : "=v"(r) : "v"(lo), "v"(hi)); return r; }
typedef float f32x2 __attribute__((ext_vector_type(2)));
__device__ __forceinline__ float epi_act(float x, int act) {
    const float sg = __builtin_amdgcn_rcpf(1.f + __expf(-x)); return act == 0 ? x : (act == 1 ? sg : x * sg);
}
struct EpiBf16Plain {
    static constexpr bool PERM = true, AFTER_DRAIN = false;
    bf16_t* O; int ldc; int amap;
    __device__ __forceinline__ void operator()(const f32x4 (&accin)[2][2][4][2], const Unit& u, int wr, int wc, int fr, int fq) const {
        const int row0 = u.pm * BM + wr * 64 + fr, col0 = u.pn * BM + wc * 32 + 8 * fq;
        int act = 0;
        if (amap) { const int pn = u.pn; act = (pn >= 12 && pn < 16) ? 1 : (((pn >= 16 && pn < 20) || pn == 26 || pn == 27 || pn >= 30) ? 2 : 0); }
        if (act) {
#pragma unroll
            for (int ai = 0; ai < 2; ++ai)
#pragma unroll
                for (int m = 0; m < 4; ++m) { bf16_t* rowp = O + (size_t)(row0 + ai * HALF + m * 16) * ldc + col0;
#pragma unroll
                    for (int bj = 0; bj < 2; ++bj) { const f32x4 v0 = accin[ai][bj][m][0], v1 = accin[ai][bj][m][1];
                        u32x4 w; w.x = cvt_pk_bf16(epi_act(v0[0], act), epi_act(v0[1], act)); w.y = cvt_pk_bf16(epi_act(v0[2], act), epi_act(v0[3], act));
                        w.z = cvt_pk_bf16(epi_act(v1[0], act), epi_act(v1[1], act)); w.w = cvt_pk_bf16(epi_act(v1[2], act), epi_act(v1[3], act));
                        *(u32x4*)(rowp + bj * HALF) = w; } }
            return;
        }
        const f32x4 (&acc)[2][2][4][2] = accin;
#pragma unroll
        for (int ai = 0; ai < 2; ++ai)
#pragma unroll
            for (int m = 0; m < 4; ++m) { bf16_t* rowp = O + (size_t)(row0 + ai * HALF + m * 16) * ldc + col0;
#pragma unroll
                for (int bj = 0; bj < 2; ++bj) { const f32x4 v0 = acc[ai][bj][m][0], v1 = acc[ai][bj][m][1];
                    u32x4 w; w.x = cvt_pk_bf16(v0[0], v0[1]); w.y = cvt_pk_bf16(v0[2], v0[3]); w.z = cvt_pk_bf16(v1[0], v1[1]); w.w = cvt_pk_bf16(v1[2], v1[3]);
                    *(u32x4*)(rowp + bj * HALF) = w; } }
    }
};
typedef unsigned u32x2e __attribute__((ext_vector_type(2)));
struct EpiKV {
    static constexpr bool PERM = false, AFTER_DRAIN = false;
    float* mk; float* mv; bf16_t* kb;
    __device__ __forceinline__ void operator()(const f32x4 (&acc)[2][2][4][2], const Unit& u, int wr, int wc, int fr, int fq) const {
        const int row0 = u.pm * BM + wr * 64 + fr, col0 = u.pn * BM + wc * 32 + 4 * fq;
        const bool isk = (u.pn < 2);
#pragma unroll
        for (int ai = 0; ai < 2; ++ai)
#pragma unroll
            for (int m = 0; m < 4; ++m) { const size_t r = (size_t)(row0 + ai * HALF + m * 16);
#pragma unroll
                for (int bj = 0; bj < 2; ++bj)
#pragma unroll
                    for (int n = 0; n < 2; ++n) { const int c = col0 + bj * HALF + n * 16; const f32x4 v = acc[ai][bj][m][n];
                        if (isk) { *(f32x4*)(mk + r * 512 + c) = v; u32x2e w; w.x = cvt_pk_bf16(v[0], v[1]); w.y = cvt_pk_bf16(v[2], v[3]); *(u32x2e*)(kb + r * 512 + c) = w; }
                        else     { *(f32x4*)(mv + r * 512 + (c - 512)) = v; } } }
    }
};
struct EpiOut {
    static constexpr bool PERM = false, AFTER_DRAIN = false;
    const float* xa; const float* xb; int split; float* out;
    __device__ __forceinline__ void operator()(const f32x4 (&acc)[2][2][4][2], const Unit& u, int wr, int wc, int fr, int fq) const {
        const int row0 = u.pm * BM + wr * 64 + fr, col0 = u.pn * BM + wc * 32 + 4 * fq;
        const float* xbase = (u.pm * BM < split) ? xa : (xb - (size_t)split * 1024);
#pragma unroll
        for (int ai = 0; ai < 2; ++ai)
#pragma unroll
            for (int m = 0; m < 4; ++m) { const size_t off = (size_t)(row0 + ai * HALF + m * 16) * 1024 + col0;
#pragma unroll
                for (int bj = 0; bj < 2; ++bj)
#pragma unroll
                    for (int n = 0; n < 2; ++n) { const f32x4 xv = *(const f32x4*)(xbase + off + bj * HALF + n * 16); *(f32x4*)(out + off + bj * HALF + n * 16) = xv + acc[ai][bj][m][n]; }
                if (m & 1) asm volatile("" ::: "memory"); }
    }
};

template <class Epi, class Sched, bool ALIGN_EPI = false, bool SP2 = false>
__device__ __forceinline__ void gemm_phase(PG8_LAS unsigned char* lds, const Gemm g, const Sched& S, const Epi& E) {
    const int tid = threadIdx.x, wid = __builtin_amdgcn_readfirstlane(tid >> 6), lane = tid & 63, wr = wid >> 2, wc = wid & 3, fr = lane & 15, fq = lane >> 4;
    const int K = g.K, nt = K / BK;
    unsigned voffA[2], voffB[2];
#pragma unroll
    for (int i = 0; i < 2; ++i) { int R, C; stage_rc(tid * 16 + i * 8192, R, C); const int Rb = Epi::PERM ? ((R & ~31) + perm32(R & 31)) : R;
        voffA[i] = (unsigned)(R * K + C) * 2u; voffB[i] = (unsigned)(Rb * K + C) * 2u; }
    const size_t kstep = (size_t)(BK * 2);
    const size_t hstep = (size_t)HALF * K * 2;
    const size_t tstep = 2 * hstep;
    const unsigned ldsw = (unsigned)wid * 1024u;
    const int aoff = lds_byte(wr * 64 + fr, fq * 8), boff = lds_byte(wc * 32 + fr, fq * 8);
#define PG8_SA(b, h) (((b) * 2 + (h)) * HTB)
#define PG8_SB(b, h) ((4 + (b) * 2 + (h)) * HTB)
#define PG8_STAGE(bufoff, gbase, voff) do { _Pragma("unroll") for (int _i = 0; _i < 2; ++_i) \
        __builtin_amdgcn_global_load_lds((const unsigned*)((const char*)(gbase) + (voff)[_i]), (PG8_LAS unsigned*)(lds + (bufoff) + ldsw + _i * 8192), 16, 0, 0); } while (0)
#define PG8_LDA(dst, b, h) do { _Pragma("unroll") for (int m = 0; m < 4; ++m) _Pragma("unroll") for (int k = 0; k < 2; ++k) dst[m][k] = *(const PG8_LAS bf16x8*)(lds + PG8_SA(b, h) + aoff + m * 2048 + k * 1024); } while (0)
#define PG8_LDB(dst, b, h) do { _Pragma("unroll") for (int n = 0; n < 2; ++n) _Pragma("unroll") for (int k = 0; k < 2; ++k) dst[n][k] = *(const PG8_LAS bf16x8*)(lds + PG8_SB(b, h) + boff + n * 2048 + k * 1024); } while (0)
#define PG8_MMA(ai, bj, At, Bt) do { __builtin_amdgcn_s_setprio(1); _Pragma("unroll") for (int m = 0; m < 4; ++m) _Pragma("unroll") for (int n = 0; n < 2; ++n) _Pragma("unroll") for (int k = 0; k < 2; ++k) \
        acc[ai][bj][m][n] = __builtin_amdgcn_mfma_f32_16x16x32_bf16(Bt[n][k], At[m][k], acc[ai][bj][m][n], 0, 0, 0); __builtin_amdgcn_s_setprio(0); } while (0)
#define PG8_WAIT_V(n) asm volatile("s_waitcnt vmcnt(" #n ")" ::: "memory")
#define PG8_WAIT_L(n) asm volatile("s_waitcnt lgkmcnt(" #n ")" ::: "memory")
#define PG8_BAR __builtin_amdgcn_s_barrier()
#define PG8_SCHED __builtin_amdgcn_sched_barrier(0)
    Unit cur, nxt; int ui = 0;
    if (!S.next(0, cur)) return;
    f32x4 acc[2][2][4][2];
#pragma unroll
    for (int a = 0; a < 2; ++a)
#pragma unroll
        for (int b = 0; b < 2; ++b)
#pragma unroll
            for (int m = 0; m < 4; ++m)
#pragma unroll
                for (int n = 0; n < 2; ++n) acc[a][b][m][n] = (f32x4){0.f, 0.f, 0.f, 0.f};
    bf16x8 At[4][2], B0[2][2], B1[2][2];
    const char* cA = (const char*)g.A + (size_t)cur.pm * tstep; const char* cB = (const char*)g.Bt + (size_t)cur.pn * tstep;
    S.a_ready(cur);
    if constexpr (SP2) {
        PG8_STAGE(PG8_SB(0, 0), cB, voffB); PG8_STAGE(PG8_SB(0, 1), cB + hstep, voffB); PG8_STAGE(PG8_SA(0, 0), cA, voffA); PG8_STAGE(PG8_SA(0, 1), cA + hstep, voffA);
        if (wr == 1) PG8_BAR;
        PG8_WAIT_V(2); PG8_BAR;
        PG8_STAGE(PG8_SB(1, 0), cB + kstep, voffB); PG8_STAGE(PG8_SA(1, 0), cA + kstep, voffA); PG8_STAGE(PG8_SB(1, 1), cB + hstep + kstep, voffB);
        PG8_WAIT_V(6); PG8_BAR;
    } else {
        PG8_STAGE(PG8_SB(0, 0), cB, voffB); PG8_STAGE(PG8_SA(0, 0), cA, voffA); PG8_STAGE(PG8_SB(0, 1), cB + hstep, voffB); PG8_STAGE(PG8_SA(0, 1), cA + hstep, voffA);
        if (wr == 1) PG8_BAR;
        PG8_WAIT_V(4); PG8_BAR;
        PG8_STAGE(PG8_SB(1, 0), cB + kstep, voffB); PG8_STAGE(PG8_SA(1, 0), cA + kstep, voffA); PG8_STAGE(PG8_SB(1, 1), cB + hstep + kstep, voffB);
        PG8_WAIT_V(6); PG8_BAR;
    }
    for (;;) {
        const bool has_next = S.next(ui + 1, nxt);
        const char* nA = has_next ? (const char*)g.A + (size_t)nxt.pm * tstep : cA; const char* nB = has_next ? (const char*)g.Bt + (size_t)nxt.pn * tstep : cB;
        for (int t = 0; t < nt; t += 2) {
            const bool last = (t == nt - 2);
            const char* a1 = cA + (size_t)(t + 1) * kstep;
            const char* a2 = last ? nA : cA + (size_t)(t + 2) * kstep; const char* b2 = last ? nB : cB + (size_t)(t + 2) * kstep;
            const char* a3 = a2 + kstep; const char* b3 = b2 + kstep;
            if (last && has_next) S.a_ready(nxt);
            if constexpr (SP2) {
            PG8_LDB(B0, 0, 0); PG8_LDB(B1, 0, 1); PG8_SCHED; PG8_LDA(At, 0, 0); PG8_STAGE(PG8_SA(1, 1), a1 + hstep, voffA);
            PG8_WAIT_V(8); PG8_WAIT_L(0); PG8_BAR; PG8_MMA(0, 0, At, B0); PG8_MMA(0, 1, At, B1); PG8_BAR; PG8_SCHED;
            PG8_LDA(At, 0, 1); PG8_STAGE(PG8_SB(0, 0), b2, voffB); PG8_STAGE(PG8_SB(0, 1), b2 + hstep, voffB); PG8_STAGE(PG8_SA(0, 0), a2, voffA);
            PG8_WAIT_V(8); PG8_WAIT_L(0); PG8_BAR; PG8_MMA(1, 0, At, B0); PG8_MMA(1, 1, At, B1); PG8_BAR; PG8_SCHED;
            PG8_LDB(B0, 1, 0); PG8_LDB(B1, 1, 1); PG8_SCHED; PG8_LDA(At, 1, 0); PG8_STAGE(PG8_SA(0, 1), a2 + hstep, voffA);
            PG8_WAIT_V(8); PG8_WAIT_L(0); PG8_BAR; PG8_MMA(0, 0, At, B0); PG8_MMA(0, 1, At, B1); PG8_BAR; PG8_SCHED;
            PG8_LDA(At, 1, 1); PG8_STAGE(PG8_SB(1, 0), b3, voffB); PG8_STAGE(PG8_SB(1, 1), b3 + hstep, voffB); PG8_STAGE(PG8_SA(1, 0), a3, voffA);
            PG8_WAIT_V(8); PG8_WAIT_L(0); PG8_BAR; PG8_MMA(1, 0, At, B0); PG8_MMA(1, 1, At, B1); PG8_BAR; PG8_SCHED;
            } else {
            PG8_LDB(B0, 0, 0); PG8_SCHED; PG8_LDA(At, 0, 0); PG8_STAGE(PG8_SA(1, 1), a1 + hstep, voffA);
            PG8_WAIT_L(8); PG8_BAR; PG8_WAIT_L(0); PG8_MMA(0, 0, At, B0); PG8_BAR; PG8_SCHED;
            PG8_LDB(B1, 0, 1); PG8_STAGE(PG8_SB(0, 0), b2, voffB);
            PG8_BAR; PG8_WAIT_L(0); PG8_MMA(0, 1, At, B1); PG8_BAR;
            PG8_LDA(At, 0, 1); PG8_STAGE(PG8_SA(0, 0), a2, voffA);
            PG8_BAR; PG8_WAIT_L(0); PG8_MMA(1, 0, At, B0); PG8_BAR; PG8_SCHED;
            PG8_STAGE(PG8_SB(0, 1), b2 + hstep, voffB);
            PG8_WAIT_V(6); PG8_BAR; PG8_MMA(1, 1, At, B1); PG8_BAR;
            PG8_LDB(B0, 1, 0); PG8_SCHED; PG8_LDA(At, 1, 0); PG8_STAGE(PG8_SA(0, 1), a2 + hstep, voffA);
            PG8_WAIT_L(8); PG8_BAR; PG8_WAIT_L(0); PG8_MMA(0, 0, At, B0); PG8_BAR; PG8_SCHED;
            PG8_LDB(B1, 1, 1); PG8_STAGE(PG8_SB(1, 0), b3, voffB);
            PG8_BAR; PG8_WAIT_L(0); PG8_MMA(0, 1, At, B1); PG8_BAR;
            PG8_LDA(At, 1, 1); PG8_STAGE(PG8_SA(1, 0), a3, voffA);
            PG8_BAR; PG8_WAIT_L(0); PG8_MMA(1, 0, At, B0); PG8_BAR; PG8_SCHED;
            PG8_STAGE(PG8_SB(1, 1), b3 + hstep, voffB);
            PG8_WAIT_V(6); PG8_BAR; PG8_MMA(1, 1, At, B1); PG8_BAR;
            }
        }
        if constexpr (ALIGN_EPI) { if (wr == 0) PG8_BAR; }
        if constexpr (!Epi::AFTER_DRAIN) { E(acc, cur, wr, wc, fr, fq); S.done(cur); }
        if (!has_next) break;
#pragma unroll
        for (int a = 0; a < 2; ++a)
#pragma unroll
            for (int b = 0; b < 2; ++b)
#pragma unroll
                for (int m = 0; m < 4; ++m)
#pragma unroll
                    for (int n = 0; n < 2; ++n) acc[a][b][m][n] = (f32x4){0.f, 0.f, 0.f, 0.f};
        cur = nxt; cA = nA; cB = nB; ++ui;
        if constexpr (ALIGN_EPI) { if (wr == 1) PG8_BAR; }
    }
    PG8_WAIT_V(0);
    if constexpr (!ALIGN_EPI) { if (wr == 0) PG8_BAR; }
    PG8_BAR;
    if constexpr (Epi::AFTER_DRAIN) { E.fused(acc, cur, wr, wc, fr, fq, lds, wid, lane); S.done(cur); }
#undef PG8_SA
#undef PG8_SB
#undef PG8_STAGE
#undef PG8_LDA
#undef PG8_LDB
#undef PG8_MMA
#undef PG8_WAIT_V
#undef PG8_WAIT_L
#undef PG8_BAR
#undef PG8_SCHED
}
}
#define GAS __attribute__((address_space(1)))
#define LAS __attribute__((address_space(3)))
typedef unsigned short bf16;
typedef unsigned v4u __attribute__((ext_vector_type(4)));
typedef float f32x4 __attribute__((ext_vector_type(4)));
typedef short bf16x8 __attribute__((ext_vector_type(8)));
typedef GAS unsigned gu32;
typedef GAS unsigned long long gu64;
#define RLX_AGENT __ATOMIC_RELAXED, __HIP_MEMORY_SCOPE_AGENT
#define LDS_WAIT() asm volatile("s_waitcnt lgkmcnt(0)" ::: "memory")
#define VM_WAIT() asm volatile("s_waitcnt vmcnt(0)" ::: "memory")
__device__ __forceinline__ unsigned long long rt() { return __builtin_amdgcn_s_memrealtime(); }
__device__ __forceinline__ unsigned f2bf(float f) { unsigned u = __builtin_bit_cast(unsigned, f); return (u + 0x7fffu + ((u >> 16) & 1u)) >> 16; }
__device__ __forceinline__ unsigned pk2(float lo, float hi) { return f2bf(lo) | (f2bf(hi) << 16); }

#define XB_TMO      128
#define XB_XCNT(j)  (256  + 64 * (j))
#define XB_XSUB(j)  (1280 + 64 * (j))
#define XB_XGEN(j)  (2304 + 64 * (j))
#define XB_TOP      3328
#define XB_TOPGEN   3392
#define XCD_BAR_WORDS 3456
#define XB_SPIN_CAP (1u << 18)

__device__ __forceinline__ unsigned xb_ld(unsigned* p)              { return __hip_atomic_load(p, __ATOMIC_RELAXED, __HIP_MEMORY_SCOPE_AGENT); }
__device__ __forceinline__ unsigned xb_add(unsigned* p, unsigned v) { return __hip_atomic_fetch_add(p, v, __ATOMIC_RELAXED, __HIP_MEMORY_SCOPE_AGENT); }
__device__ __forceinline__ unsigned xb_xcc_id() { return (unsigned)__builtin_amdgcn_s_getreg((3 << 11) | 20) & 0xFu; }
#define XB_SPIN(cond, bar) do { unsigned _sp = 0; while (cond) { __builtin_amdgcn_s_sleep(1); \
    if ((++_sp & 255u) == 0u) { if (xb_ld(&(bar)[XB_TMO])) break; if (_sp > XB_SPIN_CAP) { atomicAdd(&(bar)[XB_TMO], 1u); break; } } } } while (0)

struct XcdBarrier {
    unsigned* bar; unsigned x;
    volatile LAS unsigned* st;
};

__device__ __forceinline__ XcdBarrier xcd_barrier_post(unsigned* bar, volatile LAS unsigned* st) {
    XcdBarrier b; b.bar = bar; b.x = xb_xcc_id(); b.st = st;
    if (threadIdx.x == 0) (void)xb_add(&bar[XB_XCNT(b.x)], 1u);
    return b;
}
__device__ __forceinline__ void xcd_barrier_complete(unsigned* bar, unsigned x, unsigned& nloc, unsigned& nx) {
    const unsigned G = gridDim.x * gridDim.y * gridDim.z;
    unsigned sum, cnt, mine, sp = 0u;
    for (;;) {
        sum = 0u; cnt = 0u; mine = 0u;
#pragma unroll
        for (unsigned j = 0; j < 16; ++j) { const unsigned c = xb_ld(&bar[XB_XCNT(j)]); sum += c; cnt += (c > 0u) ? 1u : 0u; mine = (j == x) ? c : mine; }
        if (sum == G) break;
        __builtin_amdgcn_s_sleep(1);
        if ((++sp & 255u) == 0u) { if (xb_ld(&bar[XB_TMO])) break; if (sp > XB_SPIN_CAP) { atomicAdd(&bar[XB_TMO], 1u); break; } }
    }
    nloc = mine > 0u ? mine : 1u; nx = cnt > 0u ? cnt : 1u;
}

__device__ __forceinline__ void xcd_barrier(const XcdBarrier& b) {
    asm volatile("s_waitcnt vmcnt(0)" ::: "memory");
    __syncthreads();
    if (threadIdx.x == 0) {
        unsigned* bar = b.bar;
        __builtin_amdgcn_s_waitcnt(0);
        unsigned nloc = b.st[0], nx = b.st[1];
        if (nloc == 0u) { xcd_barrier_complete(bar, b.x, nloc, nx); b.st[0] = nloc; b.st[1] = nx; }
        const unsigned old = xb_add(&bar[XB_XSUB(b.x)], 1u);
        const unsigned gen = old / nloc;
        if (old + 1u == (gen + 1u) * nloc) {
            __builtin_amdgcn_fence(__ATOMIC_RELEASE, "agent");
            asm volatile("s_waitcnt vmcnt(0)" ::: "memory");
            const unsigned og = xb_add(&bar[XB_TOP], 1u);
            const unsigned tg = og / nx;
            if (og + 1u == (tg + 1u) * nx) xb_add(&bar[XB_TOPGEN], 1u);
            else XB_SPIN(xb_ld(&bar[XB_TOPGEN]) == tg, bar);
            __builtin_amdgcn_fence(__ATOMIC_ACQUIRE, "agent");
            xb_add(&bar[XB_XGEN(b.x)], 1u);
            asm volatile("s_waitcnt vmcnt(0)" ::: "memory");
        } else {
            XB_SPIN(xb_ld(&bar[XB_XGEN(b.x)]) == gen, bar);
            __builtin_amdgcn_fence(__ATOMIC_ACQUIRE, "agent");
            asm volatile("s_waitcnt vmcnt(0)" ::: "memory");
        }
    }
    __syncthreads();
}

#define DI __device__ __forceinline__
typedef float f32x16 __attribute__((ext_vector_type(16)));
typedef unsigned u32x2 __attribute__((ext_vector_type(2)));
typedef float f32x2v __attribute__((ext_vector_type(2)));
typedef __bf16 bf16x2_t __attribute__((ext_vector_type(2)));
#define MFMA32(a, b, c) __builtin_amdgcn_mfma_f32_32x32x16_bf16((a), (b), (c), 0, 0, 0)
#define MFMA16(a, b, c) __builtin_amdgcn_mfma_f32_16x16x32_bf16((a), (b), (c), 0, 0, 0)

DI unsigned cvtpk(float lo, float hi) { f32x2v v = {lo, hi}; bf16x2_t b = __builtin_convertvector(v, bf16x2_t); return __builtin_bit_cast(unsigned, b); }
DI float bf_lo(unsigned w) { return __uint_as_float(w << 16); }
DI float bf_hi(unsigned w) { return __uint_as_float(w & 0xffff0000u); }
DI float sigmoid_f(float x) { return __builtin_amdgcn_rcpf(1.f + __expf(-x)); }
DI float silu_f(float x) { return x * __builtin_amdgcn_rcpf(1.f + __expf(-x)); }
DI float wave_sum(float v) {
#pragma unroll
    for (int o = 1; o < 64; o <<= 1) v += __shfl_xor(v, o);
    return v;
}
DI float wave_max(float v) {
#pragma unroll
    for (int o = 1; o < 64; o <<= 1) v = fmaxf(v, __shfl_xor(v, o));
    return v;
}
DI int crow(int r, int hi) { return (r & 3) + 8 * (r >> 2) + 4 * hi; }
DI bf16x8 pack8(const f32x16& x, int s) {
    v4u p; p.x = cvtpk(x[8 * s + 0], x[8 * s + 1]); p.y = cvtpk(x[8 * s + 2], x[8 * s + 3]); p.z = cvtpk(x[8 * s + 4], x[8 * s + 5]); p.w = cvtpk(x[8 * s + 6], x[8 * s + 7]);
    return __builtin_bit_cast(bf16x8, p);
}

constexpr int DM = 1024, NB = 8, SEQ = 2048, MP = NB * SEQ, DB = 128, DS = 8, MS = DB * DS, MT = MP + MS;
constexpr int NPROJ = 8192, INCOLS = 8200, NMEMTOK = 256, MMEM = NB * NMEMTOK;
constexpr int PC_Q = 0, PC_K = 1024, PC_V = 2048, PC_O = 3072, PC_Z = 4096, PC_BG = 5120, PC_CG = 5632, PC_XC = 6144, PC_ZCV = 6656, PC_QX = 7168, PC_ZX = 7680;
constexpr int YC_ML = 0, YC_CV = 1024, YC_XA = 1536, NMIX = 2048;
constexpr float EPS = 1e-6f;
constexpr size_t O_YP = 0, O_YS = (size_t)MP * DM, O_CP = O_YS + (size_t)MS * DM, O_NP = O_CP + (size_t)NB * 4 * 65536, O_MP = O_NP + NB * 4 * 256, O_CVP = O_MP + NB * 4,
                 O_MK = O_CVP + NB * 2 * 512, O_MV = O_MK + (size_t)MMEM * 512, O_CS = O_MV + (size_t)MMEM * 512, O_NS = O_CS + (size_t)DB * 4 * 65536, O_MS = O_NS + DB * 4 * 256,
                 O_CVS = O_MS + DB * 4, O_END = O_CVS + DB * 2 * 512;
static_assert(O_END == 55853600, "d_out map");
constexpr size_t MiB = 1u << 20;
constexpr size_t WS_CTL = 0, CTL_ZERO_BYTES = 1 * MiB;
constexpr size_t WS_WIN = 2 * MiB, WS_WOUT = 18 * MiB, WS_WKV = 22 * MiB, WS_MEMN = 24 * MiB, WS_KMEM = 28 * MiB, WS_VT = 30 * MiB, WS_GATES = 32 * MiB, WS_XN = 34 * MiB, WS_YMIX = 68 * MiB,
                 WS_PROJ = 136 * MiB, WS_END = 408 * MiB;
static_assert(WS_XN + (size_t)MT * DM * 2 <= WS_YMIX && WS_YMIX + (size_t)MT * NMIX * 2 <= WS_PROJ && WS_PROJ + (size_t)MT * NPROJ * 2 <= WS_END, "d_ws map");
constexpr int CW_BAR = 4096, CW_QHEAD = 32768;
constexpr int LDS_BYTES = 147456, MISC_OFF = LDS_BYTES - 256;

DI void p0_transpose_item(const float* W, int ldw, int srccol, int k0, bf16* WT, int K, int dstrow, float scale, LAS float* scr, int lane) {
#pragma unroll 8
    for (int i = 0; i < 32; ++i) { const int kk = 2 * i + (lane >> 5); scr[kk * 33 + (lane & 31)] = W[(size_t)(k0 + kk) * ldw + srccol + (lane & 31)]; }
    LDS_WAIT(); asm volatile("" ::: "memory");
    const int c = lane & 7;
#pragma unroll
    for (int j = 0; j < 4; ++j) { const int n = (lane >> 3) + 8 * j; const LAS float* s = scr + (8 * c) * 33 + n;
        v4u o; o.x = pk2(s[0 * 33] * scale, s[1 * 33] * scale); o.y = pk2(s[2 * 33] * scale, s[3 * 33] * scale); o.z = pk2(s[4 * 33] * scale, s[5 * 33] * scale); o.w = pk2(s[6 * 33] * scale, s[7 * 33] * scale);
        *(GAS v4u*)(WT + (size_t)(dstrow + n) * K + k0 + 8 * c) = o; }
    LDS_WAIT(); asm volatile("" ::: "memory");
}
DI void xn_row(const float* xrow, const float* g, bf16* orow, float* gates_row, const LAS float* gw, const float* b_if, int lane) {
    const f32x4* xr = (const f32x4*)xrow + lane;
    f32x4 v[4]; float s = 0.f;
#pragma unroll
    for (int j = 0; j < 4; ++j) { v[j] = xr[64 * j]; s += (v[j].x * v[j].x + v[j].y * v[j].y) + (v[j].z * v[j].z + v[j].w * v[j].w); }
    const float r = rsqrtf(wave_sum(s) * (1.f / 1024.f) + EPS);
    if (gates_row) {
        float dot[8];
#pragma unroll
        for (int q = 0; q < 8; ++q) { float a = 0.f;
#pragma unroll
            for (int j = 0; j < 4; ++j) { const f32x4 w = *(const LAS f32x4*)(gw + q * 1024 + 256 * j + 4 * lane); a += (v[j].x * w.x + v[j].y * w.y) + (v[j].z * w.z + v[j].w * w.w); }
            dot[q] = wave_sum(a); }
        float mine = dot[0];
#pragma unroll
        for (int q = 1; q < 8; ++q) mine = (lane == q) ? dot[q] : mine;
        if (lane < 8) { float pre = mine * r + b_if[lane];
            if (lane >= 4) pre = (pre >= 0.f) ? -log1pf(expf(-pre)) : (pre - log1pf(expf(pre)));
            gates_row[lane] = pre; }
    }
    const f32x4* g4 = (const f32x4*)g + lane;
    u32x2* o8 = (u32x2*)orow + lane;
#pragma unroll
    for (int j = 0; j < 4; ++j) { const f32x4 gv = g4[64 * j]; u32x2 o; o.x = cvtpk(v[j].x * r * gv.x, v[j].y * r * gv.y); o.y = cvtpk(v[j].z * r * gv.z, v[j].w * r * gv.w); o8[64 * j] = o; }
}

constexpr int SC_Q = 0, SC_K = 32768, SC_V = 65536, SC_SM = 98304, SC_HS = 106496, SC_MISC = 139264, SC_GSET = 1536;
constexpr int SM_A = SC_MISC, SM_G = SC_MISC + 256, SM_WI = SC_MISC + 512, SM_WS = SC_MISC + 768, SM_HDMIN = SC_MISC + 1024, SM_SCAL = SC_MISC + 1280,
              SM_RSP = SC_MISC + 3072, SM_QN = SC_MISC + 3584, SM_HINV = SC_MISC + 3840, SM_N = SC_MISC + 4096, SM_GH = SC_MISC + 5120;
static_assert(SM_SCAL + 16 <= SC_MISC + SC_GSET && SM_GH + 1024 <= MISC_OFF, "scan LDS map");
#define LF(off) (*(LAS float*)(lds + (off)))
#define OPAQUE(x) asm volatile("" : "+v"(x))
#define SCAN_BAR() do { asm volatile("s_waitcnt lgkmcnt(0)" ::: "memory"); __builtin_amdgcn_s_barrier(); asm volatile("" ::: "memory"); } while (0)
typedef short v4i16_t __attribute__((ext_vector_type(4)));
DI int skey(int row) { return ((row & 3) << 2) | ((-(row >> 2)) & 3); }
DI bf16x8 tr_frag(LAS unsigned char* p0, LAS unsigned char* p1) {
    const v4i16_t lo = __builtin_amdgcn_ds_read_tr16_b64_v4i16((LAS v4i16_t*)p0), hi = __builtin_amdgcn_ds_read_tr16_b64_v4i16((LAS v4i16_t*)p1);
    return (bf16x8){lo[0], lo[1], lo[2], lo[3], hi[0], hi[1], hi[2], hi[3]};
}
DI void glds16(const void* gsrc, unsigned lds_dst) { unsigned keep;
    asm volatile("s_mov_b32 %0, m0\n\ts_mov_b32 m0, %2\n\ts_nop 0\n\tglobal_load_lds_dwordx4 %1, off\n\ts_mov_b32 m0, %0" : "=&s"(keep) : "v"(gsrc), "s"(lds_dst) : "memory"); }
DI void dma_tile(LAS unsigned char* lds, int tile_off, const bf16* src  , int w, int lane) {
    const int rsub = lane >> 5, pc = lane & 31; const unsigned lbase = (unsigned)(unsigned long)(lds + tile_off);
#pragma unroll
    for (int i = 0; i < 4; ++i) { const int row = 2 * (4 * w + i) + rsub; const int lc = pc ^ skey(row & 15);
        glds16(src + (size_t)row * NPROJ + lc * 8, (unsigned)__builtin_amdgcn_readfirstlane((int)(lbase + (unsigned)((4 * w + i) * 1024)))); }
}
DI float scan_gates(LAS unsigned char* lds, int set, float gi, float gf, float m_run, int lane) {
    float F = gf;
#pragma unroll
    for (int o = 1; o < 64; o <<= 1) { const float t = __shfl_up(F, o); if (lane >= o) F += t; }
    const float a = gi - F;
    float cm = a;
#pragma unroll
    for (int o = 1; o < 64; o <<= 1) { const float t = __shfl_up(cm, o); if (lane >= o) cm = fmaxf(cm, t); }
    const float g = fmaxf(m_run, cm);
    const float g63 = __shfl(g, 63), F63 = __shfl(F, 63);
    const int so = set * SC_GSET;
    LF(SM_A + so + lane * 4) = a; LF(SM_G + so + lane * 4) = g; LF(SM_WI + so + lane * 4) = __expf(m_run - g); LF(SM_WS + so + lane * 4) = __expf(a - g63); LF(SM_HDMIN + so + lane * 4) = __expf(-(F + g));
    if (lane == 0) { LF(SM_SCAL + so) = __expf(m_run - g63); LF(SM_SCAL + so + 4) = F63 + g63; }
    return F63 + g63;
}
DI void scan_job(LAS unsigned char* lds, int bh, const bf16* PROJ, const float* GATES, const float* g_head, bf16* YMIX, float* outC, float* outN, float* outM, int tid0) {
    const int w = __builtin_amdgcn_readfirstlane(tid0 >> 6);
    const int b = bh >> 2, h = bh & 3;
    const size_t row_base = (size_t)b * SEQ;
    constexpr int NCH = SEQ / 64;
    f32x16 Cacc[8];
#pragma unroll
    for (int i = 0; i < 8; ++i)
#pragma unroll
        for (int r = 0; r < 16; ++r) Cacc[i][r] = 0.f;
    float m_run = 0.f;
    if (tid0 < 256) { LF(SM_N + tid0 * 4) = 0.f; LF(SM_GH + tid0 * 4) = g_head[h * 256 + tid0]; }
    { const int lane = tid0 & 63; const bf16* p = PROJ + row_base * NPROJ + h * 256;
      dma_tile(lds, SC_Q, p + PC_Q, w, lane); dma_tile(lds, SC_K, p + PC_K, w, lane); dma_tile(lds, SC_V, p + PC_V, w, lane);
      if (w == 0) m_run = scan_gates(lds, 0, GATES[(row_base + lane) * 8 + h], GATES[(row_base + lane) * 8 + 4 + h], 0.f, lane); }
    asm volatile("s_waitcnt vmcnt(0)" ::: "memory");
    __syncthreads();
#pragma unroll 1
    for (int c = 0; c < NCH; ++c) {
        int tid = tid0; OPAQUE(tid);
        const int lane = tid & 63, hh = lane >> 5, l31 = lane & 31, l15 = lane & 15, lq = lane >> 4;
        const int gq = (lane & 15) >> 2, gp = lane & 3, g1 = (lane >> 4) & 1;
        const size_t r0 = row_base + (size_t)c * 64;
        const int gs = (c & 1) * SC_GSET, gsn = ((c + 1) & 1) * SC_GSET;
        const bool more = (c + 1 < NCH);
        float ngi = 0.f, ngf = 0.f;
        if (w == 0 && more) { ngi = GATES[(r0 + 64 + lane) * 8 + h]; ngf = GATES[(r0 + 64 + lane) * 8 + 4 + h]; }
        unsigned pf0 = 0u, pf1 = 0u, pf2 = 0u;
        if (c + 2 < NCH) { const bf16* pb = PROJ + (r0 + 128) * NPROJ + h * 256;
            { const int e = tid; const int rr = e >> 3, q8 = e & 7; pf0 = *(const unsigned*)(pb + (size_t)rr * NPROJ + (q8 >> 2) * 1024 + (q8 & 3) * 64); }
            { const int e = tid; const int rr = e >> 3, q8 = e & 7; pf1 = *(const unsigned*)(pb + (size_t)rr * NPROJ + (2 + (q8 >> 2)) * 1024 + (q8 & 3) * 64); }
            if (tid < 256) { const int rr = tid >> 2, q4 = tid & 3; pf2 = *(const unsigned*)(pb + (size_t)rr * NPROJ + 4 * 1024 + q4 * 64); } }
        { const int rt = w >> 1, ct0 = (w & 1) * 2;
          f32x4 sacc[2]; sacc[0] = (f32x4){0.f, 0.f, 0.f, 0.f}; sacc[1] = sacc[0];
          const int kq = skey(l15);
          const int abase = SC_Q + (16 * rt + l15) * 512, bbase = SC_K + (16 * ct0 + l15) * 512;
#pragma unroll
          for (int ks = 0; ks < 8; ++ks) { const int co = (((4 * ks + lq) ^ kq) << 4); const bf16x8 af = *(const LAS bf16x8*)(lds + abase + co);
#pragma unroll
              for (int n = 0; n < 2; ++n) { const bf16x8 bf = *(const LAS bf16x8*)(lds + bbase + n * 16 * 512 + co); sacc[n] = MFMA16(af, bf, sacc[n]); } }
          float gt[4], rs[4];
#pragma unroll
          for (int j = 0; j < 4; ++j) { gt[j] = LF(SM_G + gs + (16 * rt + 4 * lq + j) * 4); rs[j] = 0.f; }
#pragma unroll
          for (int n = 0; n < 2; ++n) { const int s = 16 * (ct0 + n) + l15; const float as = LF(SM_A + gs + s * 4);
#pragma unroll
              for (int j = 0; j < 4; ++j) { const int t = 16 * rt + 4 * lq + j; const float dcy = (s <= t) ? __expf(as - gt[j]) : 0.f; const float v = sacc[n][j] * dcy; rs[j] += v;
                  *(LAS unsigned short*)(lds + SC_SM + t * 128 + ((((s >> 3) ^ ((t >> 1) & 7))) << 4) + (s & 7) * 2) = (unsigned short)f2bf(v); } }
#pragma unroll
          for (int j = 0; j < 4; ++j) { float v = rs[j]; v += __shfl_xor(v, 1); v += __shfl_xor(v, 2); v += __shfl_xor(v, 4); v += __shfl_xor(v, 8);
              if (l15 == 0) LF(SM_RSP + ((w & 1) * 64 + 16 * rt + 4 * lq + j) * 4) = v; }
        }
        { const int t = tid >> 3, part = tid & 7; float acc = 0.f; const int kt = skey(t & 15);
#pragma unroll
          for (int cc = 0; cc < 4; ++cc) { const int cx = 4 * part + cc; const v4u qv = *(const LAS v4u*)(lds + SC_Q + t * 512 + ((cx ^ kt) << 4));
              const f32x4 n0 = *(const LAS f32x4*)(lds + SM_N + cx * 32), n1 = *(const LAS f32x4*)(lds + SM_N + cx * 32 + 16);
              acc += bf_lo(qv.x) * n0.x + bf_hi(qv.x) * n0.y + bf_lo(qv.y) * n0.z + bf_hi(qv.y) * n0.w + bf_lo(qv.z) * n1.x + bf_hi(qv.z) * n1.y + bf_lo(qv.w) * n1.z + bf_hi(qv.w) * n1.w; }
          acc += __shfl_xor(acc, 1); acc += __shfl_xor(acc, 2); acc += __shfl_xor(acc, 4);
          if (part == 0) LF(SM_QN + t * 4) = acc;
        }
        SCAN_BAR();
        if (tid < 64) { const float rowsum = LF(SM_RSP + tid * 4) + LF(SM_RSP + 256 + tid * 4); const float den = LF(SM_WI + gs + tid * 4) * LF(SM_QN + tid * 4) + rowsum;
            LF(SM_HINV + tid * 4) = 1.f / fmaxf(fabsf(den), LF(SM_HDMIN + gs + tid * 4)); }
        if (w == 0 && more) m_run = scan_gates(lds, (c + 1) & 1, ngi, ngf, m_run, lane);
        f32x16 num[2];
#pragma unroll
        for (int r = 0; r < 16; ++r) { num[0][r] = 0.f; num[1][r] = 0.f; }
        { const int kq = skey(l31 & 15), kh = kq >> 2, kl = kq & 3; const int qb0 = SC_Q + l31 * 512 + 8 * hh;
          int pa[4][4];
#pragma unroll
          for (int il = 0; il < 4; ++il)
#pragma unroll
            for (int lo2 = 0; lo2 < 4; ++lo2) pa[il][lo2] = qb0 + ((((il ^ kh) << 2) + (lo2 ^ kl)) << 4);
#pragma unroll
          for (int i = 0; i < 8; ++i)
#pragma unroll
            for (int s2 = 0; s2 < 2; ++s2) { const bf16x8 bfr = pack8(Cacc[i], s2);
#pragma unroll
                for (int tt = 0; tt < 2; ++tt) { const u32x2 lo = *(const LAS u32x2*)(lds + pa[i & 3][2 * s2] + (i >> 2) * 256 + tt * 32 * 512), hi = *(const LAS u32x2*)(lds + pa[i & 3][2 * s2 + 1] + (i >> 2) * 256 + tt * 32 * 512);
                    v4u av; av.x = lo.x; av.y = lo.y; av.z = hi.x; av.w = hi.y;
                    num[tt] = MFMA32(__builtin_bit_cast(bf16x8, av), bfr, num[tt]); }
                if (s2 == 1 && (i & 1)) __builtin_amdgcn_sched_barrier(0); } }
#pragma unroll
        for (int tt = 0; tt < 2; ++tt)
#pragma unroll
            for (int r = 0; r < 16; ++r) num[tt][r] *= LF(SM_WI + gs + (32 * tt + crow(r, hh)) * 4);
        { const int x = 2 * g1 + (gp >> 1); const int k1 = hh ? 2 : 0, k2 = hh ? 1 : 3;
          const int ro = (8 * hh + gq) * 512 + 8 * (gp & 1);
          const int c1 = (((4 * w) ^ (4 * gq)) + (x ^ k1)) << 4, c2 = (((4 * w) ^ (4 * gq)) + (x ^ k2)) << 4;
          const int sw = (l31 >> 1) & 7;
#pragma unroll
          for (int ks = 0; ks < 4; ++ks) { const bf16x8 vf = tr_frag(lds + SC_V + ks * 8192 + ro + c1, lds + SC_V + ks * 8192 + ro + 4 * 512 + c2);
#pragma unroll
            for (int tt = 0; tt < 2; ++tt) { const bf16x8 afr = *(const LAS bf16x8*)(lds + SC_SM + (32 * tt + l31) * 128 + (((2 * ks + hh) ^ sw) << 4)); num[tt] = MFMA32(afr, vf, num[tt]); } } }
        SCAN_BAR();
#pragma unroll
        for (int tt = 0; tt < 2; ++tt)
#pragma unroll
            for (int r = 0; r < 16; ++r) { const int t = 32 * tt + crow(r, hh);
                *(LAS unsigned short*)(lds + SC_HS + t * 512 + ((w ^ (t & 7)) << 6) + l31 * 2) = (unsigned short)f2bf(num[tt][r] * LF(SM_HINV + t * 4)); }
        u32x2 ov[8], zv[8];
        { const int t = tid >> 3, part = tid & 7; const bf16* po = PROJ + (r0 + t) * NPROJ + PC_O + h * 256 + 4 * part;
#pragma unroll
          for (int q = 0; q < 8; ++q) { ov[q] = *(const u32x2*)(po + 32 * q); zv[q] = *(const u32x2*)(po + (PC_Z - PC_O) + 32 * q); } }
        if (more) dma_tile(lds, SC_Q, PROJ + (r0 + 64) * NPROJ + h * 256 + PC_Q, w, lane);
        { const float wC = LF(SM_SCAL + gs);
          const int x = 2 * g1 + (gp >> 1); const int k1 = hh ? 2 : 0, k2 = hh ? 1 : 3;
          const int ro = (8 * hh + gq) * 512 + 8 * (gp & 1);
          bf16x8 bw[4];
          { const int c1 = (((4 * w) ^ (4 * gq)) + (x ^ k1)) << 4, c2 = (((4 * w) ^ (4 * gq)) + (x ^ k2)) << 4;
#pragma unroll
          for (int ks = 0; ks < 4; ++ks) { const v4u vb = __builtin_bit_cast(v4u, tr_frag(lds + SC_V + ks * 8192 + ro + c1, lds + SC_V + ks * 8192 + ro + 4 * 512 + c2));
              const f32x4 w0 = *(const LAS f32x4*)(lds + SM_WS + gs + (16 * ks + 8 * hh) * 4), w1 = *(const LAS f32x4*)(lds + SM_WS + gs + (16 * ks + 8 * hh) * 4 + 16);
              v4u o; o.x = cvtpk(bf_lo(vb.x) * w0.x, bf_hi(vb.x) * w0.y); o.y = cvtpk(bf_lo(vb.y) * w0.z, bf_hi(vb.y) * w0.w); o.z = cvtpk(bf_lo(vb.z) * w1.x, bf_hi(vb.z) * w1.y); o.w = cvtpk(bf_lo(vb.w) * w1.z, bf_hi(vb.w) * w1.w);
              bw[ks] = __builtin_bit_cast(bf16x8, o); } }
#pragma unroll
          for (int i = 0; i < 8; ++i) {
#pragma unroll
              for (int r = 0; r < 16; ++r) Cacc[i][r] *= wC;
              const int c1 = (((4 * i) ^ (4 * gq)) + (x ^ k1)) << 4, c2 = (((4 * i) ^ (4 * gq)) + (x ^ k2)) << 4;
#pragma unroll
              for (int ks = 0; ks < 4; ++ks) { const bf16x8 afr = tr_frag(lds + SC_K + ks * 8192 + ro + c1, lds + SC_K + ks * 8192 + ro + 4 * 512 + c2); Cacc[i] = MFMA32(afr, bw[ks], Cacc[i]); } }
          if (tid < 256) { const int d = tid; float acc = 0.f; const int dc = d >> 3, db = (d & 7) * 2;
#pragma unroll 1
              for (int s16 = 0; s16 < 4; ++s16) {
#pragma unroll
                  for (int sl = 0; sl < 16; ++sl) acc += LF(SM_WS + gs + (16 * s16 + sl) * 4) * bf_lo((unsigned)*(const LAS unsigned short*)(lds + SC_K + (16 * s16 + sl) * 512 + ((dc ^ skey(sl)) << 4) + db)); }
              LF(SM_N + d * 4) = wC * LF(SM_N + d * 4) + acc; }
        }
        SCAN_BAR();
        asm volatile("" :: "v"(ov[0]), "v"(ov[1]), "v"(ov[2]), "v"(ov[3]), "v"(ov[4]), "v"(ov[5]), "v"(ov[6]), "v"(ov[7]), "v"(zv[0]), "v"(zv[1]), "v"(zv[2]), "v"(zv[3]), "v"(zv[4]), "v"(zv[5]), "v"(zv[6]), "v"(zv[7]));
        if (more) { const bf16* p = PROJ + (r0 + 64) * NPROJ + h * 256; dma_tile(lds, SC_K, p + PC_K, w, lane); dma_tile(lds, SC_V, p + PC_V, w, lane); }
        { const int t = tid >> 3, part = tid & 7; const size_t row = r0 + t;
          const int hb = SC_HS + t * 512 + part * 8, tb = (t & 7);
          float ho[32]; float ssq = 0.f;
#pragma unroll
          for (int q = 0; q < 8; ++q) { const u32x2 hv = *(const LAS u32x2*)(lds + hb + ((q ^ tb) << 6));
              ho[4 * q + 0] = bf_lo(ov[q].x) * bf_lo(hv.x); ho[4 * q + 1] = bf_hi(ov[q].x) * bf_hi(hv.x); ho[4 * q + 2] = bf_lo(ov[q].y) * bf_lo(hv.y); ho[4 * q + 3] = bf_hi(ov[q].y) * bf_hi(hv.y);
              ssq += (ho[4 * q] * ho[4 * q] + ho[4 * q + 1] * ho[4 * q + 1]) + (ho[4 * q + 2] * ho[4 * q + 2] + ho[4 * q + 3] * ho[4 * q + 3]); }
          ssq += __shfl_xor(ssq, 1); ssq += __shfl_xor(ssq, 2); ssq += __shfl_xor(ssq, 4);
          const float rr = rsqrtf(ssq * (1.f / 256.f) + EPS);
          bf16* yp = YMIX + row * NMIX + YC_ML + h * 256 + 4 * part;
#pragma unroll
          for (int q = 0; q < 8; ++q) { const f32x4 gh = *(const LAS f32x4*)(lds + SM_GH + (32 * q + 4 * part) * 4);
              u32x2 o; o.x = cvtpk(ho[4 * q] * rr * gh.x * bf_lo(zv[q].x), ho[4 * q + 1] * rr * gh.y * bf_hi(zv[q].x));
              o.y = cvtpk(ho[4 * q + 2] * rr * gh.z * bf_lo(zv[q].y), ho[4 * q + 3] * rr * gh.w * bf_hi(zv[q].y));
              *(u32x2*)(yp + 32 * q) = o; }
        }
        asm volatile("" :: "v"(pf0), "v"(pf1), "v"(pf2));
        asm volatile("s_waitcnt vmcnt(0)" ::: "memory"); SCAN_BAR();
    }
    { const int lane = tid0 & 63, hh = lane >> 5, l31 = lane & 31;
#pragma unroll
      for (int i = 0; i < 8; ++i)
#pragma unroll
        for (int r = 0; r < 16; ++r) outC[((size_t)bh * 256 + 32 * i + crow(r, hh)) * 256 + 32 * w + l31] = Cacc[i][r];
      if (tid0 < 256) outN[bh * 256 + tid0] = LF(SM_N + tid0 * 4);
      if (tid0 == 0) outM[bh] = m_run; }
    __syncthreads();
}

constexpr int AT_K = 0, AT_KP = 272, AT_VT = 69632, AT_VP = 520, AT_SUM = AT_VT + 128 * AT_VP;
static_assert(AT_SUM + 1024 <= MISC_OFF, "attention LDS map");
DI void attn_prompt_unit(LAS unsigned char* lds, int unit, const bf16* PROJ, const bf16* KMEM, const bf16* VT, bf16* YMIX, int tid) {
    const int lane = tid & 63, w = __builtin_amdgcn_readfirstlane(tid >> 6), hh = lane >> 5, l31 = lane & 31;
    const int b = unit >> 5, h = (unit >> 3) & 3, qb = unit & 7;
#pragma unroll
    for (int i = 0; i < 8; ++i) { const int idx = tid + 512 * i; const int key = idx >> 4, cx = idx & 15;
        const v4u v = *(const v4u*)(KMEM + (size_t)(b * 256 + key) * 512 + h * 128 + cx * 8); *(LAS v4u*)(lds + AT_K + key * AT_KP + cx * 16) = v; }
#pragma unroll
    for (int i = 0; i < 8; ++i) { const int idx = tid + 512 * i; const int d = idx >> 5, cx = idx & 31;
        const v4u v = *(const v4u*)(VT + (size_t)(h * 128 + d) * 2048 + b * 256 + cx * 8);
        u32x2 a, c; a.x = v.x; a.y = v.y; c.x = v.z; c.y = v.w;
        *(LAS u32x2*)(lds + AT_VT + d * AT_VP + cx * 16) = a; *(LAS u32x2*)(lds + AT_VT + d * AT_VP + cx * 16 + 8) = c; }
    __syncthreads();
    const size_t row0 = (size_t)b * SEQ + qb * 256 + 32 * w;
    const float c2 = 0.08838834764831845f * 1.4426950408889634f;
    float m_run = -3.0e38f, l_run = 0.f;
    f32x16 O[4];
#pragma unroll
    for (int dt = 0; dt < 4; ++dt)
#pragma unroll
        for (int r = 0; r < 16; ++r) O[dt][r] = 0.f;
    const bf16* qp = PROJ + (row0 + l31) * NPROJ + PC_QX + h * 128 + 8 * hh;
    const int kb0 = AT_K + l31 * AT_KP + hh * 16, vb0 = AT_VT + l31 * AT_VP + hh * 8;
#pragma unroll
    for (int half = 0; half < 2; ++half) {
        f32x16 acc[4];
#pragma unroll
        for (int kt = 0; kt < 4; ++kt)
#pragma unroll
            for (int r = 0; r < 16; ++r) acc[kt][r] = 0.f;
#pragma unroll
        for (int kh = 0; kh < 2; ++kh) {
            bf16x8 qf[4];
#pragma unroll
            for (int k4 = 0; k4 < 4; ++k4) qf[k4] = *(const bf16x8*)(qp + 16 * (4 * kh + k4));
#pragma unroll
            for (int k4 = 0; k4 < 4; ++k4)
#pragma unroll
                for (int kt = 0; kt < 4; ++kt) { const bf16x8 af = *(const LAS bf16x8*)(lds + kb0 + (4 * half + kt) * 32 * AT_KP + (4 * kh + k4) * 32); acc[kt] = MFMA32(af, qf[k4], acc[kt]); } }
        float mx = m_run;
#pragma unroll
        for (int kt = 0; kt < 4; ++kt)
#pragma unroll
            for (int r = 0; r < 16; ++r) mx = fmaxf(mx, acc[kt][r]);
        mx = fmaxf(mx, __shfl_xor(mx, 32));
        const float alpha = __builtin_amdgcn_exp2f((m_run - mx) * c2);
        m_run = mx;
        float sum = 0.f;
        bf16x8 pk[4][2];
#pragma unroll
        for (int kt = 0; kt < 4; ++kt) {
#pragma unroll
            for (int r = 0; r < 16; ++r) { const float p = __builtin_amdgcn_exp2f((acc[kt][r] - mx) * c2); acc[kt][r] = p; sum += p; }
            pk[kt][0] = pack8(acc[kt], 0); pk[kt][1] = pack8(acc[kt], 1); }
        sum += __shfl_xor(sum, 32);
        l_run = l_run * alpha + sum;
        if (half == 1) {
            __syncthreads();
            if (hh == 0) LF(AT_SUM + (w * 32 + l31) * 4) = alpha;
#pragma unroll
            for (int r = 0; r < 16; ++r) { const float al = LF(AT_SUM + (w * 32 + crow(r, hh)) * 4);
#pragma unroll
                for (int dt = 0; dt < 4; ++dt) O[dt][r] *= al; }
        }
#pragma unroll
        for (int kt = 0; kt < 4; ++kt)
#pragma unroll
            for (int s2 = 0; s2 < 2; ++s2)
#pragma unroll
                for (int dt = 0; dt < 4; ++dt) { const int o = vb0 + dt * 32 * AT_VP + (8 * (4 * half + kt) + 4 * s2) * 8;
                    const u32x2 lo = *(const LAS u32x2*)(lds + o), hi = *(const LAS u32x2*)(lds + o + 16);
                    v4u bv; bv.x = lo.x; bv.y = lo.y; bv.z = hi.x; bv.w = hi.y;
                    O[dt] = MFMA32(pk[kt][s2], __builtin_bit_cast(bf16x8, bv), O[dt]); }
    }
    asm volatile("s_waitcnt lgkmcnt(0)" ::: "memory");
    if (hh == 0) LF(AT_SUM + (w * 32 + l31) * 4) = l_run;
    { const int stg = AT_K + w * (32 * 264);
#pragma unroll
      for (int r = 0; r < 16; ++r) { const int q = crow(r, hh); const float inv = 1.f / LF(AT_SUM + (w * 32 + q) * 4);
#pragma unroll
        for (int dt = 0; dt < 4; ++dt) *(LAS unsigned short*)(lds + stg + q * 264 + (32 * dt + l31) * 2) = (unsigned short)f2bf(O[dt][r] * inv); }
#pragma unroll
      for (int i = 0; i < 8; ++i) { const int q = 4 * i + (lane >> 4), cx = lane & 15; const size_t row = row0 + q;
        const u32x2 oa = *(const LAS u32x2*)(lds + stg + q * 264 + cx * 16), ob = *(const LAS u32x2*)(lds + stg + q * 264 + cx * 16 + 8);
        const v4u zv = *(const v4u*)(PROJ + row * NPROJ + PC_ZX + h * 128 + cx * 8);
        v4u y; y.x = cvtpk(bf_lo(oa.x) * bf_lo(zv.x), bf_hi(oa.x) * bf_hi(zv.x)); y.y = cvtpk(bf_lo(oa.y) * bf_lo(zv.y), bf_hi(oa.y) * bf_hi(zv.y));
        y.z = cvtpk(bf_lo(ob.x) * bf_lo(zv.z), bf_hi(ob.x) * bf_hi(zv.z)); y.w = cvtpk(bf_lo(ob.y) * bf_lo(zv.w), bf_hi(ob.y) * bf_hi(zv.w));
        *(v4u*)(YMIX + row * NMIX + YC_XA + h * 128 + cx * 8) = y; } }
    __syncthreads();
}

constexpr int SS_QT = 0, SS_K = 8192, SS_V = 16384, SS_KWT = 24576, SS_QC = 32768;
DI void smlstm_unit(LAS unsigned char* lds, int bh, const bf16* PROJ, const float* GATES, const float* C0, const float* n0, const float* m0p, const float* g_head, bf16* YMIX,
                    float* outC, float* outN, float* outM, int tid) {
    const int lane = tid & 63, w = __builtin_amdgcn_readfirstlane(tid >> 6);
    const int b = bh >> 2, h = bh & 3;
    const size_t rowb = (size_t)MP + (size_t)b * 8;
    f32x4 q4, k4;
    { const bf16* p = PROJ + (rowb + w) * NPROJ + h * 256 + 4 * lane;
      const u32x2 qv = *(const u32x2*)(p + PC_Q), kv = *(const u32x2*)(p + PC_K), vv = *(const u32x2*)(p + PC_V);
      q4 = (f32x4){bf_lo(qv.x), bf_hi(qv.x), bf_lo(qv.y), bf_hi(qv.y)}; k4 = (f32x4){bf_lo(kv.x), bf_hi(kv.x), bf_lo(kv.y), bf_hi(kv.y)};
      const f32x4 v4 = (f32x4){bf_lo(vv.x), bf_hi(vv.x), bf_lo(vv.y), bf_hi(vv.y)};
      *(LAS f32x4*)(lds + SS_K + (w * 256 + 4 * lane) * 4) = k4; *(LAS f32x4*)(lds + SS_V + (w * 256 + 4 * lane) * 4) = v4;
#pragma unroll
      for (int i = 0; i < 4; ++i) LF(SS_QT + ((4 * lane + i) * 8 + w) * 4) = q4[i];
      *(LAS f32x4*)(lds + SS_QC + (w * 256 + 4 * lane) * 4) = (f32x4){0.f, 0.f, 0.f, 0.f}; }
    const float m0 = m0p[bh];
    float F[8], a[8], g[8], wsv[8];
    { float run = 0.f, cm = 0.f;
#pragma unroll
      for (int s = 0; s < 8; ++s) { const float gi = GATES[(rowb + s) * 8 + h], gf = GATES[(rowb + s) * 8 + 4 + h]; run += gf; F[s] = run; a[s] = gi - run; cm = (s == 0) ? a[0] : fmaxf(cm, a[s]); g[s] = fmaxf(m0, cm); } }
    const float g7 = g[7], wC = __expf(m0 - g7), m_new = F[7] + g7;
#pragma unroll
    for (int s = 0; s < 8; ++s) wsv[s] = __expf(a[s] - g7);
    float st[8], winter_t, hinv_t;
    { float gt = g[0], Ft = F[0], wsw = wsv[0];
#pragma unroll
      for (int s = 1; s < 8; ++s) { gt = (w == s) ? g[s] : gt; Ft = (w == s) ? F[s] : Ft; wsw = (w == s) ? wsv[s] : wsw; }
#pragma unroll
      for (int i = 0; i < 4; ++i) LF(SS_KWT + ((4 * lane + i) * 8 + w) * 4) = k4[i] * wsw;
      __syncthreads();
      float part[8];
#pragma unroll
      for (int s = 0; s < 8; ++s) { const f32x4 ks = *(const LAS f32x4*)(lds + SS_K + (s * 256 + 4 * lane) * 4); part[s] = wave_sum((q4.x * ks.x + q4.y * ks.y) + (q4.z * ks.z + q4.w * ks.w)); }
      const f32x4 n4 = *(const f32x4*)(n0 + (size_t)bh * 256 + 4 * lane);
      const float pn = wave_sum((q4.x * n4.x + q4.y * n4.y) + (q4.z * n4.z + q4.w * n4.w));
      float rowsum = 0.f;
#pragma unroll
      for (int s = 0; s < 8; ++s) { const float dcy = (s <= w) ? __expf(a[s] - gt) : 0.f; st[s] = part[s] * dcy; rowsum += st[s]; }
      winter_t = __expf(m0 - gt);
      const float den = winter_t * pn + rowsum;
      hinv_t = 1.f / fmaxf(fabsf(den), __expf(-(Ft + gt)));
    }
    f32x4 v4[8];
#pragma unroll
    for (int s = 0; s < 8; ++s) v4[s] = *(const LAS f32x4*)(lds + SS_V + (s * 256 + 4 * lane) * 4);
    f32x4 acc[8];
#pragma unroll
    for (int t = 0; t < 8; ++t) acc[t] = (f32x4){0.f, 0.f, 0.f, 0.f};
    const float* Cp = C0 + (size_t)bh * 65536 + 4 * lane; float* Co = outC + (size_t)bh * 65536 + 4 * lane;
#pragma unroll 4
    for (int r = 0; r < 32; ++r) { const int d = w + 8 * r;
        const f32x4 c4 = *(const f32x4*)(Cp + (size_t)d * 256);
        const f32x4 qa = *(const LAS f32x4*)(lds + SS_QT + d * 32), qb = *(const LAS f32x4*)(lds + SS_QT + d * 32 + 16);
        const f32x4 ka = *(const LAS f32x4*)(lds + SS_KWT + d * 32), kb = *(const LAS f32x4*)(lds + SS_KWT + d * 32 + 16);
        acc[0] += qa.x * c4; acc[1] += qa.y * c4; acc[2] += qa.z * c4; acc[3] += qa.w * c4; acc[4] += qb.x * c4; acc[5] += qb.y * c4; acc[6] += qb.z * c4; acc[7] += qb.w * c4;
        f32x4 cn = c4 * wC;
        cn += ka.x * v4[0]; cn += ka.y * v4[1]; cn += ka.z * v4[2]; cn += ka.w * v4[3]; cn += kb.x * v4[4]; cn += kb.y * v4[5]; cn += kb.z * v4[6]; cn += kb.w * v4[7];
        *(f32x4*)(Co + (size_t)d * 256) = cn; }
#pragma unroll
    for (int t = 0; t < 8; ++t)
#pragma unroll
        for (int i = 0; i < 4; ++i) __hip_atomic_fetch_add((LAS float*)(lds + SS_QC + (t * 256 + 4 * lane + i) * 4), acc[t][i], __ATOMIC_RELAXED, __HIP_MEMORY_SCOPE_WORKGROUP);
    if (tid < 256) { const int d = tid; const f32x4 ka = *(const LAS f32x4*)(lds + SS_KWT + d * 32), kb = *(const LAS f32x4*)(lds + SS_KWT + d * 32 + 16);
        outN[(size_t)bh * 256 + d] = wC * n0[(size_t)bh * 256 + d] + ((ka.x + ka.y) + (ka.z + ka.w)) + ((kb.x + kb.y) + (kb.z + kb.w)); }
    if (tid == 0) outM[bh] = m_new;
    __syncthreads();
    { const f32x4 qc = *(const LAS f32x4*)(lds + SS_QC + (w * 256 + 4 * lane) * 4);
      f32x4 num = qc * winter_t;
#pragma unroll
      for (int s = 0; s < 8; ++s) num += st[s] * v4[s];
      const f32x4 hv = num * hinv_t;
      const size_t row = rowb + w;
      const u32x2 ov = *(const u32x2*)(PROJ + row * NPROJ + PC_O + h * 256 + 4 * lane), zv = *(const u32x2*)(PROJ + row * NPROJ + PC_Z + h * 256 + 4 * lane);
      const f32x4 ho = (f32x4){bf_lo(ov.x) * hv.x, bf_hi(ov.x) * hv.y, bf_lo(ov.y) * hv.z, bf_hi(ov.y) * hv.w};
      const float ssq = wave_sum((ho.x * ho.x + ho.y * ho.y) + (ho.z * ho.z + ho.w * ho.w));
      const float rr = rsqrtf(ssq * (1.f / 256.f) + EPS);
      const f32x4 gh = *(const f32x4*)(g_head + h * 256 + 4 * lane);
      u32x2 o; o.x = cvtpk(ho.x * rr * gh.x * bf_lo(zv.x), ho.y * rr * gh.y * bf_hi(zv.x)); o.y = cvtpk(ho.z * rr * gh.z * bf_lo(zv.y), ho.w * rr * gh.w * bf_hi(zv.y));
      *(u32x2*)(YMIX + row * NMIX + YC_ML + h * 256 + 4 * lane) = o; }
    __syncthreads();
}

constexpr int SA_Q = 0, SA_S = 4096, SA_K = 16384, SA_PART = 86016;
DI void sattn_unit(LAS unsigned char* lds, int bh, const bf16* PROJ, const float* ck, const float* cv, bf16* YMIX, int tid) {
    const int lane = tid & 63, w = __builtin_amdgcn_readfirstlane(tid >> 6);
    const int b = bh >> 2, h = bh & 3;
    const size_t rowb = (size_t)MP + (size_t)b * 8;
    if (tid < 256) { const int t = tid >> 5, d = (tid & 31) * 4; const u32x2 qv = *(const u32x2*)(PROJ + (rowb + t) * NPROJ + PC_QX + h * 128 + d);
        *(LAS f32x4*)(lds + SA_Q + (t * 128 + d) * 4) = (f32x4){bf_lo(qv.x), bf_hi(qv.x), bf_lo(qv.y), bf_hi(qv.y)}; }
#pragma unroll 1
    for (int half = 0; half < 2; ++half) {
#pragma unroll
        for (int i = 0; i < 8; ++i) { const int idx = tid + 512 * i; const int key = idx >> 5, c4 = idx & 31;
            const f32x4 v = *(const f32x4*)(ck + ((size_t)(b * 256 + half * 128 + key) * 4 + h) * 128 + c4 * 4); *(LAS f32x4*)(lds + SA_K + key * 528 + c4 * 16) = v; }
        __syncthreads();
        { const int key = tid & 127, tg = tid >> 7; float a0 = 0.f, a1 = 0.f;
#pragma unroll 8
          for (int c4 = 0; c4 < 32; ++c4) { const f32x4 kx = *(const LAS f32x4*)(lds + SA_K + key * 528 + c4 * 16);
              const f32x4 qa = *(const LAS f32x4*)(lds + SA_Q + ((2 * tg) * 128 + 4 * c4) * 4), qb = *(const LAS f32x4*)(lds + SA_Q + ((2 * tg + 1) * 128 + 4 * c4) * 4);
              a0 += (kx.x * qa.x + kx.y * qa.y) + (kx.z * qa.z + kx.w * qa.w); a1 += (kx.x * qb.x + kx.y * qb.y) + (kx.z * qb.z + kx.w * qb.w); }
          LF(SA_S + ((2 * tg) * 256 + half * 128 + key) * 4) = a0 * 0.08838834764831845f; LF(SA_S + ((2 * tg + 1) * 256 + half * 128 + key) * 4) = a1 * 0.08838834764831845f; }
        __syncthreads();
    }
    { f32x4 s4 = *(const LAS f32x4*)(lds + SA_S + (w * 256 + 4 * lane) * 4);
      const float mx = wave_max(fmaxf(fmaxf(s4.x, s4.y), fmaxf(s4.z, s4.w)));
      s4.x = __expf(s4.x - mx); s4.y = __expf(s4.y - mx); s4.z = __expf(s4.z - mx); s4.w = __expf(s4.w - mx);
      const float inv = 1.f / wave_sum((s4.x + s4.y) + (s4.z + s4.w));
      *(LAS f32x4*)(lds + SA_S + (w * 256 + 4 * lane) * 4) = s4 * inv; }
    __syncthreads();
    { const int d = tid & 127, kq = tid >> 7; float acc[8];
#pragma unroll
      for (int t = 0; t < 8; ++t) acc[t] = 0.f;
      const float* vp = cv + ((size_t)(b * 256 + kq * 64) * 4 + h) * 128 + d;
#pragma unroll 8
      for (int kk = 0; kk < 64; ++kk) { const float v = vp[(size_t)kk * 512]; const int key = kq * 64 + kk;
#pragma unroll
          for (int t = 0; t < 8; ++t) acc[t] += LF(SA_S + (t * 256 + key) * 4) * v; }
#pragma unroll
      for (int t = 0; t < 8; ++t) LF(SA_PART + ((kq * 8 + t) * 128 + d) * 4) = acc[t]; }
    __syncthreads();
    { const int t = tid >> 6, d = (tid & 63) * 2; float o0 = 0.f, o1 = 0.f;
#pragma unroll
      for (int kq = 0; kq < 4; ++kq) { const f32x2v p = *(const LAS f32x2v*)(lds + SA_PART + ((kq * 8 + t) * 128 + d) * 4); o0 += p.x; o1 += p.y; }
      const size_t row = rowb + t; const unsigned zv = *(const unsigned*)(PROJ + row * NPROJ + PC_ZX + h * 128 + d);
      *(unsigned*)(YMIX + row * NMIX + YC_XA + h * 128 + d) = cvtpk(o0 * bf_lo(zv), o1 * bf_hi(zv)); }
    __syncthreads();
}

DI void conv_token(const bf16* p, const float (&w0)[8], const float (&w1)[8], const float (&w2)[8], const float (&cb)[8], float (&u2)[8], float (&u1)[8], float (&u)[8], bf16* yout) {
    const v4u bg = *(const v4u*)(p + PC_BG), cg = *(const v4u*)(p + PC_CG), xc = *(const v4u*)(p + PC_XC), zc = *(const v4u*)(p + PC_ZCV);
    float y[8];
#pragma unroll
    for (int i = 0; i < 4; ++i) {
        u[2 * i] = bf_lo(cg[i]) * bf_lo(xc[i]); u[2 * i + 1] = bf_hi(cg[i]) * bf_hi(xc[i]);
        const float yc0 = cb[2 * i] + w0[2 * i] * u2[2 * i] + w1[2 * i] * u1[2 * i] + w2[2 * i] * u[2 * i];
        const float yc1 = cb[2 * i + 1] + w0[2 * i + 1] * u2[2 * i + 1] + w1[2 * i + 1] * u1[2 * i + 1] + w2[2 * i + 1] * u[2 * i + 1];
        y[2 * i] = bf_lo(bg[i]) * yc0 * bf_lo(zc[i]); y[2 * i + 1] = bf_hi(bg[i]) * yc1 * bf_hi(zc[i]); }
    v4u o; o.x = cvtpk(y[0], y[1]); o.y = cvtpk(y[2], y[3]); o.z = cvtpk(y[4], y[5]); o.w = cvtpk(y[6], y[7]);
    *(v4u*)yout = o;
}
DI void conv_item(int item, const bf16* PROJ, const float* state_conv, const float* conv_w, const float* conv_b, bf16* YMIX, float* out_cvp, float* out_cvs, int tid) {
    const int c8 = tid & 63, sub = tid >> 6, ch = 8 * c8;
    float w0[8], w1[8], w2[8], cb[8], u2[8], u1[8], u[8];
#pragma unroll
    for (int i = 0; i < 8; ++i) { w0[i] = conv_w[ch + i]; w1[i] = conv_w[512 + ch + i]; w2[i] = conv_w[1024 + ch + i]; cb[i] = conv_b[ch + i]; }
    if (item < 64) {
        const int b = item >> 3, blk = item & 7, t0 = blk * 256 + sub * 32; const size_t rowb = (size_t)b * SEQ;
#pragma unroll
        for (int i = 0; i < 8; ++i) { u2[i] = 0.f; u1[i] = 0.f; }
        if (t0 >= 2) {
            const bf16* pa = PROJ + (rowb + t0 - 2) * NPROJ + ch; const bf16* pb = PROJ + (rowb + t0 - 1) * NPROJ + ch;
            const v4u cga = *(const v4u*)(pa + PC_CG), xca = *(const v4u*)(pa + PC_XC), cgb = *(const v4u*)(pb + PC_CG), xcb = *(const v4u*)(pb + PC_XC);
#pragma unroll
            for (int i = 0; i < 4; ++i) { u2[2 * i] = bf_lo(cga[i]) * bf_lo(xca[i]); u2[2 * i + 1] = bf_hi(cga[i]) * bf_hi(xca[i]); u1[2 * i] = bf_lo(cgb[i]) * bf_lo(xcb[i]); u1[2 * i + 1] = bf_hi(cgb[i]) * bf_hi(xcb[i]); }
        }
#pragma unroll 2
        for (int tt = 0; tt < 32; ++tt) { const int t = t0 + tt; const size_t row = rowb + t;
            conv_token(PROJ + row * NPROJ + ch, w0, w1, w2, cb, u2, u1, u, YMIX + row * NMIX + YC_CV + ch);
            if (t >= SEQ - 2) { float* o = out_cvp + ((size_t)b * 2 + (t - (SEQ - 2))) * 512 + ch; *(f32x4*)o = (f32x4){u[0], u[1], u[2], u[3]}; *(f32x4*)(o + 4) = (f32x4){u[4], u[5], u[6], u[7]}; }
#pragma unroll
            for (int i = 0; i < 8; ++i) { u2[i] = u1[i]; u1[i] = u[i]; } }
    } else {
        const int si = item - 64;
#pragma unroll 1
        for (int q = 0; q < 4; ++q) { const int seq = si * 32 + sub * 4 + q; const size_t rowb = (size_t)MP + (size_t)seq * 8;
#pragma unroll
            for (int i = 0; i < 8; ++i) { u2[i] = state_conv[((size_t)seq * 2 + 0) * 512 + ch + i]; u1[i] = state_conv[((size_t)seq * 2 + 1) * 512 + ch + i]; }
#pragma unroll 2
            for (int t = 0; t < 8; ++t) { const size_t row = rowb + t;
                conv_token(PROJ + row * NPROJ + ch, w0, w1, w2, cb, u2, u1, u, YMIX + row * NMIX + YC_CV + ch);
                if (t >= 6) { float* o = out_cvs + ((size_t)seq * 2 + (t - 6)) * 512 + ch; *(f32x4*)o = (f32x4){u[0], u[1], u[2], u[3]}; *(f32x4*)(o + 4) = (f32x4){u[4], u[5], u[6], u[7]}; }
#pragma unroll
                for (int i = 0; i < 8; ++i) { u2[i] = u1[i]; u1[i] = u[i]; } } }
    }
}
constexpr int IT_SM = 0, IT_SA = 512, IT_SC = 1024, IT_PA = 1028, IT_PC = 1284, NITEMS = 1348;

#ifndef PH_MASK
#define PH_MASK 511
#endif
#ifndef PROBE_REPEAT
#define PROBE_REPEAT -1
#endif
#ifndef PROBE_QSEL
#define PROBE_QSEL 1
#endif
constexpr int N_PHASES = 5;
struct Args { const float* in[19]; float* out; unsigned char* ws; int ph_lo, ph_hi, li, qsel; };
__global__ void __launch_bounds__(512, 2) hyb_fwd(Args args) {
    extern __shared__ __attribute__((aligned(16))) unsigned char lds_raw[];
    LAS unsigned char* lds = (LAS unsigned char*)lds_raw;
    volatile LAS unsigned* MISC = (volatile LAS unsigned*)(lds + MISC_OFF);
    const int tid = threadIdx.x, lane = tid & 63, wave = __builtin_amdgcn_readfirstlane(tid >> 6);
    const int bid = blockIdx.x, G = gridDim.x;
    unsigned char* const ws = args.ws;
    gu32* const ctl = (gu32*)(ws + WS_CTL);
#define xp ((const float*)args.in[0])
#define xs ((const float*)args.in[1])
#define st_C ((const float*)args.in[2])
#define st_n ((const float*)args.in[3])
#define st_m ((const float*)args.in[4])
#define st_conv ((const float*)args.in[5])
#define ck ((const float*)args.in[6])
#define cv ((const float*)args.in[7])
#define memp ((const float*)args.in[8])
#define g_norm ((const float*)args.in[9])
#define w_in ((const float*)args.in[10])
#define b_if ((const float*)args.in[11])
#define g_head ((const float*)args.in[12])
#define conv_w ((const float*)args.in[13])
#define conv_b ((const float*)args.in[14])
#define g_mem ((const float*)args.in[15])
#define w_kv ((const float*)args.in[16])
#define w_out ((const float*)args.in[17])
#define g_final ((const float*)args.in[18])
#define out (args.out)
#define Wt_in ((bf16*)(ws + WS_WIN))
#define Wt_out ((bf16*)(ws + WS_WOUT))
#define Wt_kv ((bf16*)(ws + WS_WKV))
#define MEMN ((bf16*)(ws + WS_MEMN))
#define KMEM ((bf16*)(ws + WS_KMEM))
#define VT ((bf16*)(ws + WS_VT))
#define GATES ((float*)(ws + WS_GATES))
#define XN ((bf16*)(ws + WS_XN))
#define YMIX ((bf16*)(ws + WS_YMIX))
#define PROJ ((bf16*)(ws + WS_PROJ))
    if (tid < 64) MISC[tid] = 0u;
    __syncthreads();
    XcdBarrier bar = xcd_barrier_post((unsigned*)(ctl + CW_BAR) + args.li * XCD_BAR_WORDS, MISC + 8);
    const int lo = args.ph_lo, hi = args.ph_hi;
#define IN(k) (lo <= (k) && (k) < hi)
#define BOTH(k) (IN(k) && IN((k) + 1))
    const int gw = bid * 8 + wave, NGW = G * 8;

    if ((PH_MASK & 1) && IN(0)) {
        LAS float* scr = (LAS float*)(lds + wave * 16384);
        constexpr int I_IN = 16 * 256, I_OUT = 32 * 32, I_KV = 16 * 32, NIT = I_IN + I_OUT + I_KV;
        for (int it = gw; it < NIT; it += NGW) {
            int r = it;
            if (r < I_IN) { const int kb = r >> 8, nb = r & 255, dstrow = 32 * nb; const int srccol = dstrow + (dstrow >= 5120 ? 8 : 0); const float sc = (dstrow >= 1024 && dstrow < 2048) ? 0.0625f : 1.f;
                p0_transpose_item(w_in, INCOLS, srccol, 64 * kb, Wt_in, 1024, dstrow, sc, scr, lane); continue; }
            r -= I_IN;
            if (r < I_OUT) { const int kb = r >> 5, nb = r & 31; p0_transpose_item(w_out, 1024, 32 * nb, 64 * kb, Wt_out, 2048, 32 * nb, 1.f, scr, lane); continue; }
            r -= I_OUT;
            { const int kb = r >> 5, nb = r & 31; p0_transpose_item(w_kv, 1024, 32 * nb, 64 * kb, Wt_kv, 1024, 32 * nb, 1.f, scr, lane); }
        }
        __syncthreads();
        LAS float* gwl = (LAS float*)lds;
        for (int e = tid; e < 8192; e += 512) { const int q = e >> 10, k = e & 1023; gwl[e] = g_norm[k] * w_in[(size_t)k * INCOLS + 5120 + q]; }
        __syncthreads();
        for (int m = gw; m < MT; m += NGW) { const float* xrow = (m < MP) ? xp + (size_t)m * DM : xs + (size_t)(m - MP) * DM; xn_row(xrow, g_norm, XN + (size_t)m * DM, GATES + (size_t)m * 8, gwl, b_if, lane); }
        for (int m = gw; m < MMEM; m += NGW) xn_row(memp + (size_t)m * DM, g_mem, MEMN + (size_t)m * DM, nullptr, gwl, b_if, lane);
        if (BOTH(0)) xcd_barrier(bar);
    }
    if ((PH_MASK & 2) && IN(1)) {
        { pg8::Gemm g{XN, Wt_in, MT, NPROJ, DM}; pg8::StaticOrder S; S.init(MT, NPROJ, G, bid); pg8::EpiBf16Plain E{PROJ, NPROJ, 1};
          pg8::gemm_phase<pg8::EpiBf16Plain, pg8::StaticOrder, true, true>(lds, g, S, E); }
        if (bid >= 128 && bid < 160) { pg8::Gemm g{MEMN, Wt_kv, MMEM, 1024, DM}; pg8::StaticOrder S; S.init(MMEM, 1024, 32, bid - 128); pg8::EpiKV E{out + O_MK, out + O_MV, KMEM};
          pg8::gemm_phase<pg8::EpiKV, pg8::StaticOrder, true, true>(lds, g, S, E); }
        if (bid >= 160 && bid < 176) { pg8::Gemm g{Wt_kv + (size_t)512 * DM, MEMN, 512, MMEM, DM}; pg8::StaticOrder S; S.init(512, MMEM, 16, bid - 160); pg8::EpiBf16Plain E{VT, MMEM, 0};
          pg8::gemm_phase<pg8::EpiBf16Plain, pg8::StaticOrder, true, true>(lds, g, S, E); }
        if (BOTH(1)) xcd_barrier(bar);
    }
    if (IN(2)) {
        __syncthreads();
        if ((PH_MASK & 4) && bid < 32) scan_job(lds, bid, PROJ, GATES, g_head, YMIX, out + O_CP, out + O_NP, out + O_MP, tid);
        for (; args.qsel < 2;) {
            if (tid == 0) MISC[4] = __hip_atomic_fetch_add(ctl + CW_QHEAD + 64 * args.qsel, 1u, RLX_AGENT);
            __syncthreads();
            const int it = (int)MISC[4];
            __syncthreads();
            if (it >= NITEMS) break;
            int tid = threadIdx.x; OPAQUE(tid);
            if (it < IT_SA) { if (PH_MASK & 8) smlstm_unit(lds, it - IT_SM, PROJ, GATES, st_C, st_n, st_m, g_head, YMIX, out + O_CS, out + O_NS, out + O_MS, tid); }
            else if (it < IT_SC) { if (PH_MASK & 16) sattn_unit(lds, it - IT_SA, PROJ, ck, cv, YMIX, tid); }
            else if (it < IT_PA) { if (PH_MASK & 32) conv_item(64 + (it - IT_SC), PROJ, st_conv, conv_w, conv_b, YMIX, out + O_CVP, out + O_CVS, tid); }
            else if (it < IT_PC) { if (PH_MASK & 64) attn_prompt_unit(lds, it - IT_PA, PROJ, KMEM, VT, YMIX, tid); }
            else { if (PH_MASK & 32) conv_item(it - IT_PC, PROJ, st_conv, conv_w, conv_b, YMIX, out + O_CVP, out + O_CVS, tid); }
        }
        if (BOTH(2)) xcd_barrier(bar);
    }
    if ((PH_MASK & 128) && IN(3)) {
        __syncthreads();
        pg8::Gemm g{YMIX, Wt_out, MT, DM, NMIX}; pg8::StaticOrder S; S.init(MT, DM, G, bid); pg8::EpiOut E{xp, xs, MP, out + O_YP};
        pg8::gemm_phase<pg8::EpiOut, pg8::StaticOrder, true, true>(lds, g, S, E);
        if (BOTH(3)) xcd_barrier(bar);
    }
    if ((PH_MASK & 256) && IN(4)) {
        for (int m = gw; m < MT; m += NGW) { f32x4* row = (f32x4*)(out + O_YP + (size_t)m * DM) + lane; f32x4 v[4]; float s = 0.f;
#pragma unroll
            for (int j = 0; j < 4; ++j) { v[j] = row[64 * j]; s += (v[j].x * v[j].x + v[j].y * v[j].y) + (v[j].z * v[j].z + v[j].w * v[j].w); }
            const float r = rsqrtf(wave_sum(s) * (1.f / 1024.f) + EPS);
#pragma unroll
            for (int j = 0; j < 4; ++j) { const f32x4 gv = ((const f32x4*)g_final)[64 * j + lane]; row[64 * j] = v[j] * r * gv; } }
    }
#undef IN
#undef BOTH
}
#undef xp
#undef xs
#undef st_C
#undef st_n
#undef st_m
#undef st_conv
#undef ck
#undef cv
#undef memp
#undef g_norm
#undef w_in
#undef b_if
#undef g_head
#undef conv_w
#undef conv_b
#undef g_mem
#undef w_kv
#undef w_out
#undef g_final
#undef out
#undef Wt_in
#undef Wt_out
#undef Wt_kv
#undef MEMN
#undef KMEM
#undef VT
#undef GATES
#undef XN
#undef YMIX
#undef PROJ

extern "C" void kernel_launch(void* const* d_in, const int* in_sizes, int n_in, void* d_out, int out_size, void* d_ws, size_t ws_size, hipStream_t stream) {
    static int grid = 0;
    if (grid == 0) {
        if (n_in != 19 || (size_t)out_size != O_END || ws_size < WS_END) { fprintf(stderr, "kernel_launch: unexpected shapes (n_in %d, out %d, ws %zu); nothing launched\n", n_in, out_size, ws_size); grid = -1; return; }
        int dev = 0, cus = 0;
        if (hipGetDevice(&dev) != hipSuccess || hipDeviceGetAttribute(&cus, hipDeviceAttributeMultiprocessorCount, dev) != hipSuccess) { grid = -1; return; }
        if (hipFuncSetAttribute((const void*)hyb_fwd, hipFuncAttributeMaxDynamicSharedMemorySize, LDS_BYTES) != hipSuccess) { fprintf(stderr, "kernel_launch: hipFuncSetAttribute failed\n"); grid = -1; return; }
        (void)hipGetLastError();
        grid = cus;
        if (grid != 256) fprintf(stderr, "kernel_launch: %d CUs; this build's phase maps assume 256\n", grid);
    }
    if (grid < 0) return;
    if (hipMemsetAsync((char*)d_ws + WS_CTL, 0, CTL_ZERO_BYTES, stream) != hipSuccess) return;
    Args a{};
    for (int i = 0; i < 19; ++i) a.in[i] = (const float*)d_in[i];
    a.out = (float*)d_out; a.ws = (unsigned char*)d_ws;
    if (PROBE_REPEAT < 0) { a.ph_lo = 0; a.ph_hi = N_PHASES; hipLaunchKernelGGL(hyb_fwd, dim3(grid), dim3(512), LDS_BYTES, stream, a); }
    else {
        a.ph_lo = 0; a.ph_hi = PROBE_REPEAT + 1; a.li = 0; a.qsel = 0; hipLaunchKernelGGL(hyb_fwd, dim3(grid), dim3(512), LDS_BYTES, stream, a);
        a.ph_lo = PROBE_REPEAT; a.ph_hi = PROBE_REPEAT + 1; a.li = 1; a.qsel = PROBE_QSEL; hipLaunchKernelGGL(hyb_fwd, dim3(grid), dim3(512), LDS_BYTES, stream, a);
        if (PROBE_REPEAT + 1 < N_PHASES) { a.ph_lo = PROBE_REPEAT + 1; a.ph_hi = N_PHASES; a.li = 2; a.qsel = 0; hipLaunchKernelGGL(hyb_fwd, dim3(grid), dim3(512), LDS_BYTES, stream, a); }
    }
}
```

```cpp
#include <hip/hip_runtime.h>
#include <cstdio>
#include <cstdint>
namespace pg8 {
#define PG8_LAS __attribute__((address_space(3)))
typedef unsigned short bf16_t;
typedef short bf16x8 __attribute__((ext_vector_type(8)));
typedef float f32x4 __attribute__((ext_vector_type(4)));
typedef unsigned u32x4 __attribute__((ext_vector_type(4)));
constexpr int BM = 256, BK = 64, HALF = 128, HTB = HALF * BK * 2  , STAGE_BYTES = 8 * HTB, NXCD = 8, WGM = 8;

__host__ __device__ __forceinline__ int lds_byte(int r, int c) { const int st = (r >> 4) * 2 + (c >> 5), rr = r & 15, cc = c & 31, ob = rr * 64 + cc * 2; return st * 1024 + (ob ^ (((ob >> 9) & 1) << 5)); }
__host__ __device__ __forceinline__ void stage_rc(int b, int& R, int& C) { const int st = b / 1024, sb = b % 1024, swz = sb ^ (((sb >> 9) & 1) << 5); R = (st >> 1) * 16 + swz / 64; C = (st & 1) * 32 + (swz % 64) / 2; }
__host__ __device__ __forceinline__ int perm32(int rho) { const int n = rho >> 4, i = rho & 15; return 8 * (i >> 2) + 4 * n + (i & 3); }

struct Unit { int pm, pn; };
struct Gemm { const bf16_t* A; const bf16_t* Bt; int M, N, K, ld; };

struct StaticOrder {
    int nM, nN, nwg, G, c;
    __host__ __device__ void init(int M, int N, int G_, int c_) { nM = M / BM; nN = N / BM; nwg = nM * nN; G = G_; c = c_; }
    __host__ __device__ bool next(int i, Unit& u) const {
        const long L = (long)i * G + c; if (L >= nwg) return false;
        int wgid = (int)L; { const int q = nwg / NXCD, r = nwg % NXCD, xcd = wgid % NXCD, off = wgid / NXCD; wgid = (xcd < r ? xcd * (q + 1) : r * (q + 1) + (xcd - r) * q) + off; }
        const int nig = WGM * nN, gid = wgid / nig, fm = gid * WGM, gsz = (nM - fm) < WGM ? (nM - fm) : WGM;
        u.pm = fm + ((wgid % nig) % gsz); u.pn = (wgid % nig) / gsz; return true;
    }
    __device__ __forceinline__ void a_ready(const Unit&) const {}
    __device__ __forceinline__ void done(const Unit&) const {}
};

__device__ __forceinline__ unsigned cvt_pk_bf16(float lo, float hi) { unsigned r; asm volatile("v_cvt_pk_bf16_f32 %0, %1, %2" : "=v"(r) : "v"(lo), "v"(hi)); return r; }
typedef float f32x2 __attribute__((ext_vector_type(2)));
__device__ __forceinline__ float epi_act(float x, int act) {
    const float sg = __builtin_amdgcn_rcpf(1.f + __expf(-x)); return act == 0 ? x : (act == 1 ? sg : x * sg);
}
struct EpiBf16Plain {
    static constexpr bool PERM = true, AFTER_DRAIN = false;
    bf16_t* O; int ldc; int amap; const float* gh;
    __device__ __forceinline__ void operator()(const f32x4 (&accin)[2][2][4][2], const Unit& u, int wr, int wc, int fr, int fq) const {
        const int row0 = u.pm * BM + wr * 64 + fr, col0 = u.pn * BM + wc * 32 + 8 * fq;
        int act = 0;
        if (amap) { const int pn = u.pn; act = (pn >= 12 && pn < 16) ? 1 : (((pn >= 16 && pn < 20) || pn == 26 || pn == 27 || pn >= 30) ? 2 : 0); }
        if (act) {
#pragma unroll
            for (int ai = 0; ai < 2; ++ai)
#pragma unroll
                for (int m = 0; m < 4; ++m) { bf16_t* rowp = O + (size_t)(row0 + ai * HALF + m * 16) * ldc + col0;
#pragma unroll
                    for (int bj = 0; bj < 2; ++bj) { const f32x4 v0 = accin[ai][bj][m][0], v1 = accin[ai][bj][m][1];
                        f32x4 g0 = (f32x4){1.f, 1.f, 1.f, 1.f}, g1 = g0;
                        if (u.pn >= 16 && u.pn < 20) { g0 = *(const f32x4*)(gh + (col0 - 4096) + bj * HALF); g1 = *(const f32x4*)(gh + (col0 - 4096) + bj * HALF + 4); }
                        u32x4 w; w.x = cvt_pk_bf16(epi_act(v0[0], act) * g0[0], epi_act(v0[1], act) * g0[1]); w.y = cvt_pk_bf16(epi_act(v0[2], act) * g0[2], epi_act(v0[3], act) * g0[3]);
                        w.z = cvt_pk_bf16(epi_act(v1[0], act) * g1[0], epi_act(v1[1], act) * g1[1]); w.w = cvt_pk_bf16(epi_act(v1[2], act) * g1[2], epi_act(v1[3], act) * g1[3]);
                        *(u32x4*)(rowp + bj * HALF) = w; } }
            return;
        }
        const f32x4 (&acc)[2][2][4][2] = accin;
#pragma unroll
        for (int ai = 0; ai < 2; ++ai)
#pragma unroll
            for (int m = 0; m < 4; ++m) { bf16_t* rowp = O + (size_t)(row0 + ai * HALF + m * 16) * ldc + col0;
#pragma unroll
                for (int bj = 0; bj < 2; ++bj) { const f32x4 v0 = acc[ai][bj][m][0], v1 = acc[ai][bj][m][1];
                    u32x4 w; w.x = cvt_pk_bf16(v0[0], v0[1]); w.y = cvt_pk_bf16(v0[2], v0[3]); w.z = cvt_pk_bf16(v1[0], v1[1]); w.w = cvt_pk_bf16(v1[2], v1[3]);
                    *(u32x4*)(rowp + bj * HALF) = w; } }
    }
};
typedef unsigned u32x2e __attribute__((ext_vector_type(2)));
struct EpiKV {
    static constexpr bool PERM = false, AFTER_DRAIN = false;
    float* mk; float* mv; bf16_t* kb;
    __device__ __forceinline__ void operator()(const f32x4 (&acc)[2][2][4][2], const Unit& u, int wr, int wc, int fr, int fq) const {
        const int row0 = u.pm * BM + wr * 64 + fr, col0 = u.pn * BM + wc * 32 + 4 * fq;
        const bool isk = (u.pn < 2);
#pragma unroll
        for (int ai = 0; ai < 2; ++ai)
#pragma unroll
            for (int m = 0; m < 4; ++m) { const size_t r = (size_t)(row0 + ai * HALF + m * 16);
#pragma unroll
                for (int bj = 0; bj < 2; ++bj)
#pragma unroll
                    for (int n = 0; n < 2; ++n) { const int c = col0 + bj * HALF + n * 16; const f32x4 v = acc[ai][bj][m][n];
                        if (isk) { *(f32x4*)(mk + r * 512 + c) = v; u32x2e w; w.x = cvt_pk_bf16(v[0], v[1]); w.y = cvt_pk_bf16(v[2], v[3]); *(u32x2e*)(kb + r * 512 + c) = w; }
                        else     { *(f32x4*)(mv + r * 512 + (c - 512)) = v; } } }
    }
};
struct EpiOut {
    static constexpr bool PERM = false, AFTER_DRAIN = false;
    const float* xa; const float* xb; int split; float* out;
    __device__ __forceinline__ void operator()(const f32x4 (&acc)[2][2][4][2], const Unit& u, int wr, int wc, int fr, int fq) const {
        const int row0 = u.pm * BM + wr * 64 + fr, col0 = u.pn * BM + wc * 32 + 4 * fq;
        const float* xbase = (u.pm * BM < split) ? xa : (xb - (size_t)split * 1024);
#pragma unroll
        for (int ai = 0; ai < 2; ++ai)
#pragma unroll
            for (int m = 0; m < 4; ++m) { const size_t off = (size_t)(row0 + ai * HALF + m * 16) * 1024 + col0;
#pragma unroll
                for (int bj = 0; bj < 2; ++bj)
#pragma unroll
                    for (int n = 0; n < 2; ++n) { const f32x4 xv = *(const f32x4*)(xbase + off + bj * HALF + n * 16); *(f32x4*)(out + off + bj * HALF + n * 16) = xv + acc[ai][bj][m][n]; }
                if (m & 1) asm volatile("" ::: "memory"); }
    }
};

struct EpiSlab {
    static constexpr bool PERM = false, AFTER_DRAIN = false;
    float* C;
    __device__ __forceinline__ void operator()(const f32x4 (&acc)[2][2][4][2], const Unit& u, int wr, int wc, int fr, int fq) const {
        const int row0 = u.pm * BM + wr * 64 + fr, col0 = u.pn * BM + wc * 32 + 4 * fq;
#pragma unroll
        for (int ai = 0; ai < 2; ++ai)
#pragma unroll
            for (int m = 0; m < 4; ++m) { float* rowp = C + (size_t)(row0 + ai * HALF + m * 16) * 1024 + col0;
#pragma unroll
                for (int bj = 0; bj < 2; ++bj)
#pragma unroll
                    for (int n = 0; n < 2; ++n) *(f32x4*)(rowp + bj * HALF + n * 16) = acc[ai][bj][m][n]; }
    }
};

template <class Epi, class Sched, bool ALIGN_EPI = false, bool SP2 = false>
__device__ __forceinline__ void gemm_phase(PG8_LAS unsigned char* lds, const Gemm g, const Sched& S, const Epi& E) {
    const int tid = threadIdx.x, wid = __builtin_amdgcn_readfirstlane(tid >> 6), lane = tid & 63, wr = wid >> 2, wc = wid & 3, fr = lane & 15, fq = lane >> 4;
    const int K = g.K, nt = K / BK;
    unsigned voffA[2], voffB[2];
#pragma unroll
    for (int i = 0; i < 2; ++i) { int R, C; stage_rc(tid * 16 + i * 8192, R, C); const int Rb = Epi::PERM ? ((R & ~31) + perm32(R & 31)) : R;
        voffA[i] = (unsigned)(R * g.ld + C) * 2u; voffB[i] = (unsigned)(Rb * g.ld + C) * 2u; }
    const size_t kstep = (size_t)(BK * 2);
    const size_t hstep = (size_t)HALF * g.ld * 2;
    const size_t tstep = 2 * hstep;
    const unsigned ldsw = (unsigned)wid * 1024u;
    const int aoff = lds_byte(wr * 64 + fr, fq * 8), boff = lds_byte(wc * 32 + fr, fq * 8);
#define PG8_SA(b, h) (((b) * 2 + (h)) * HTB)
#define PG8_SB(b, h) ((4 + (b) * 2 + (h)) * HTB)
#define PG8_STAGE(bufoff, gbase, voff) do { _Pragma("unroll") for (int _i = 0; _i < 2; ++_i) \
        __builtin_amdgcn_global_load_lds((const unsigned*)((const char*)(gbase) + (voff)[_i]), (PG8_LAS unsigned*)(lds + (bufoff) + ldsw + _i * 8192), 16, 0, 0); } while (0)
#define PG8_LDA(dst, b, h) do { _Pragma("unroll") for (int m = 0; m < 4; ++m) _Pragma("unroll") for (int k = 0; k < 2; ++k) dst[m][k] = *(const PG8_LAS bf16x8*)(lds + PG8_SA(b, h) + aoff + m * 2048 + k * 1024); } while (0)
#define PG8_LDB(dst, b, h) do { _Pragma("unroll") for (int n = 0; n < 2; ++n) _Pragma("unroll") for (int k = 0; k < 2; ++k) dst[n][k] = *(const PG8_LAS bf16x8*)(lds + PG8_SB(b, h) + boff + n * 2048 + k * 1024); } while (0)
#define PG8_MMA(ai, bj, At, Bt) do { __builtin_amdgcn_s_setprio(1); _Pragma("unroll") for (int m = 0; m < 4; ++m) _Pragma("unroll") for (int n = 0; n < 2; ++n) _Pragma("unroll") for (int k = 0; k < 2; ++k) \
        acc[ai][bj][m][n] = __builtin_amdgcn_mfma_f32_16x16x32_bf16(Bt[n][k], At[m][k], acc[ai][bj][m][n], 0, 0, 0); __builtin_amdgcn_s_setprio(0); } while (0)
#define PG8_WAIT_V(n) asm volatile("s_waitcnt vmcnt(" #n ")" ::: "memory")
#define PG8_WAIT_L(n) asm volatile("s_waitcnt lgkmcnt(" #n ")" ::: "memory")
#define PG8_BAR __builtin_amdgcn_s_barrier()
#define PG8_SCHED __builtin_amdgcn_sched_barrier(0)
    Unit cur, nxt; int ui = 0;
    if (!S.next(0, cur)) return;
    f32x4 acc[2][2][4][2];
#pragma unroll
    for (int a = 0; a < 2; ++a)
#pragma unroll
        for (int b = 0; b < 2; ++b)
#pragma unroll
            for (int m = 0; m < 4; ++m)
#pragma unroll
                for (int n = 0; n < 2; ++n) acc[a][b][m][n] = (f32x4){0.f, 0.f, 0.f, 0.f};
    bf16x8 At[4][2], B0[2][2], B1[2][2];
    const char* cA = (const char*)g.A + (size_t)cur.pm * tstep; const char* cB = (const char*)g.Bt + (size_t)cur.pn * tstep;
    S.a_ready(cur);
    if constexpr (SP2) {
        PG8_STAGE(PG8_SB(0, 0), cB, voffB); PG8_STAGE(PG8_SB(0, 1), cB + hstep, voffB); PG8_STAGE(PG8_SA(0, 0), cA, voffA); PG8_STAGE(PG8_SA(0, 1), cA + hstep, voffA);
        if (wr == 1) PG8_BAR;
        PG8_WAIT_V(2); PG8_BAR;
        PG8_STAGE(PG8_SB(1, 0), cB + kstep, voffB); PG8_STAGE(PG8_SA(1, 0), cA + kstep, voffA); PG8_STAGE(PG8_SB(1, 1), cB + hstep + kstep, voffB);
        PG8_WAIT_V(6); PG8_BAR;
    } else {
        PG8_STAGE(PG8_SB(0, 0), cB, voffB); PG8_STAGE(PG8_SA(0, 0), cA, voffA); PG8_STAGE(PG8_SB(0, 1), cB + hstep, voffB); PG8_STAGE(PG8_SA(0, 1), cA + hstep, voffA);
        if (wr == 1) PG8_BAR;
        PG8_WAIT_V(4); PG8_BAR;
        PG8_STAGE(PG8_SB(1, 0), cB + kstep, voffB); PG8_STAGE(PG8_SA(1, 0), cA + kstep, voffA); PG8_STAGE(PG8_SB(1, 1), cB + hstep + kstep, voffB);
        PG8_WAIT_V(6); PG8_BAR;
    }
    for (;;) {
        const bool has_next = S.next(ui + 1, nxt);
        const char* nA = has_next ? (const char*)g.A + (size_t)nxt.pm * tstep : cA; const char* nB = has_next ? (const char*)g.Bt + (size_t)nxt.pn * tstep : cB;
        for (int t = 0; t < nt; t += 2) {
            const bool last = (t == nt - 2);
            const char* a1 = cA + (size_t)(t + 1) * kstep;
            const char* a2 = last ? nA : cA + (size_t)(t + 2) * kstep; const char* b2 = last ? nB : cB + (size_t)(t + 2) * kstep;
            const char* a3 = a2 + kstep; const char* b3 = b2 + kstep;
            if (last && has_next) S.a_ready(nxt);
            if constexpr (SP2) {
            PG8_LDB(B0, 0, 0); PG8_LDB(B1, 0, 1); PG8_SCHED; PG8_LDA(At, 0, 0); PG8_STAGE(PG8_SA(1, 1), a1 + hstep, voffA);
            PG8_WAIT_V(8); PG8_WAIT_L(0); PG8_BAR; PG8_MMA(0, 0, At, B0); PG8_MMA(0, 1, At, B1); PG8_BAR; PG8_SCHED;
            PG8_LDA(At, 0, 1); PG8_STAGE(PG8_SB(0, 0), b2, voffB); PG8_STAGE(PG8_SB(0, 1), b2 + hstep, voffB); PG8_STAGE(PG8_SA(0, 0), a2, voffA);
            PG8_WAIT_V(8); PG8_WAIT_L(0); PG8_BAR; PG8_MMA(1, 0, At, B0); PG8_MMA(1, 1, At, B1); PG8_BAR; PG8_SCHED;
            PG8_LDB(B0, 1, 0); PG8_LDB(B1, 1, 1); PG8_SCHED; PG8_LDA(At, 1, 0); PG8_STAGE(PG8_SA(0, 1), a2 + hstep, voffA);
            PG8_WAIT_V(8); PG8_WAIT_L(0); PG8_BAR; PG8_MMA(0, 0, At, B0); PG8_MMA(0, 1, At, B1); PG8_BAR; PG8_SCHED;
            PG8_LDA(At, 1, 1); PG8_STAGE(PG8_SB(1, 0), b3, voffB); PG8_STAGE(PG8_SB(1, 1), b3 + hstep, voffB); PG8_STAGE(PG8_SA(1, 0), a3, voffA);
            PG8_WAIT_V(8); PG8_WAIT_L(0); PG8_BAR; PG8_MMA(1, 0, At, B0); PG8_MMA(1, 1, At, B1); PG8_BAR; PG8_SCHED;
            } else {
            PG8_LDB(B0, 0, 0); PG8_SCHED; PG8_LDA(At, 0, 0); PG8_STAGE(PG8_SA(1, 1), a1 + hstep, voffA);
            PG8_WAIT_L(8); PG8_BAR; PG8_WAIT_L(0); PG8_MMA(0, 0, At, B0); PG8_BAR; PG8_SCHED;
            PG8_LDB(B1, 0, 1); PG8_STAGE(PG8_SB(0, 0), b2, voffB);
            PG8_BAR; PG8_WAIT_L(0); PG8_MMA(0, 1, At, B1); PG8_BAR;
            PG8_LDA(At, 0, 1); PG8_STAGE(PG8_SA(0, 0), a2, voffA);
            PG8_BAR; PG8_WAIT_L(0); PG8_MMA(1, 0, At, B0); PG8_BAR; PG8_SCHED;
            PG8_STAGE(PG8_SB(0, 1), b2 + hstep, voffB);
            PG8_WAIT_V(6); PG8_BAR; PG8_MMA(1, 1, At, B1); PG8_BAR;
            PG8_LDB(B0, 1, 0); PG8_SCHED; PG8_LDA(At, 1, 0); PG8_STAGE(PG8_SA(0, 1), a2 + hstep, voffA);
            PG8_WAIT_L(8); PG8_BAR; PG8_WAIT_L(0); PG8_MMA(0, 0, At, B0); PG8_BAR; PG8_SCHED;
            PG8_LDB(B1, 1, 1); PG8_STAGE(PG8_SB(1, 0), b3, voffB);
            PG8_BAR; PG8_WAIT_L(0); PG8_MMA(0, 1, At, B1); PG8_BAR;
            PG8_LDA(At, 1, 1); PG8_STAGE(PG8_SA(1, 0), a3, voffA);
            PG8_BAR; PG8_WAIT_L(0); PG8_MMA(1, 0, At, B0); PG8_BAR; PG8_SCHED;
            PG8_STAGE(PG8_SB(1, 1), b3 + hstep, voffB);
            PG8_WAIT_V(6); PG8_BAR; PG8_MMA(1, 1, At, B1); PG8_BAR;
            }
        }
        if constexpr (ALIGN_EPI) { if (wr == 0) PG8_BAR; }
        if constexpr (!Epi::AFTER_DRAIN) { E(acc, cur, wr, wc, fr, fq); S.done(cur); }
        if (!has_next) break;
#pragma unroll
        for (int a = 0; a < 2; ++a)
#pragma unroll
            for (int b = 0; b < 2; ++b)
#pragma unroll
                for (int m = 0; m < 4; ++m)
#pragma unroll
                    for (int n = 0; n < 2; ++n) acc[a][b][m][n] = (f32x4){0.f, 0.f, 0.f, 0.f};
        cur = nxt; cA = nA; cB = nB; ++ui;
        if constexpr (ALIGN_EPI) { if (wr == 1) PG8_BAR; }
    }
    PG8_WAIT_V(0);
    if constexpr (!ALIGN_EPI) { if (wr == 0) PG8_BAR; }
    PG8_BAR;
    if constexpr (Epi::AFTER_DRAIN) { E.fused(acc, cur, wr, wc, fr, fq, lds, wid, lane); S.done(cur); }
#undef PG8_SA
#undef PG8_SB
#undef PG8_STAGE
#undef PG8_LDA
#undef PG8_LDB
#undef PG8_MMA
#undef PG8_WAIT_V
#undef PG8_WAIT_L
#undef PG8_BAR
#undef PG8_SCHED
}
}
#define GAS __attribute__((address_space(1)))
#define LAS __attribute__((address_space(3)))
typedef unsigned short bf16;
typedef unsigned v4u __attribute__((ext_vector_type(4)));
typedef float f32x4 __attribute__((ext_vector_type(4)));
typedef short bf16x8 __attribute__((ext_vector_type(8)));
typedef GAS unsigned gu32;
typedef GAS unsigned long long gu64;
#define RLX_AGENT __ATOMIC_RELAXED, __HIP_MEMORY_SCOPE_AGENT
#define LDS_WAIT() asm volatile("s_waitcnt lgkmcnt(0)" ::: "memory")
#define VM_WAIT() asm volatile("s_waitcnt vmcnt(0)" ::: "memory")
__device__ __forceinline__ unsigned long long rt() { return __builtin_amdgcn_s_memrealtime(); }
__device__ __forceinline__ unsigned f2bf(float f) { unsigned u = __builtin_bit_cast(unsigned, f); return (u + 0x7fffu + ((u >> 16) & 1u)) >> 16; }
__device__ __forceinline__ unsigned pk2(float lo, float hi) { return f2bf(lo) | (f2bf(hi) << 16); }

#define XB_TMO      128
#define XB_XCNT(j)  (256  + 64 * (j))
#define XB_XSUB(j)  (1280 + 64 * (j))
#define XB_XGEN(j)  (2304 + 64 * (j))
#define XB_TOP      3328
#define XB_TOPGEN   3392
#define XCD_BAR_WORDS 3456
#define XB_SPIN_CAP (1u << 18)

__device__ __forceinline__ unsigned xb_ld(unsigned* p)              { return __hip_atomic_load(p, __ATOMIC_RELAXED, __HIP_MEMORY_SCOPE_AGENT); }
__device__ __forceinline__ unsigned xb_add(unsigned* p, unsigned v) { return __hip_atomic_fetch_add(p, v, __ATOMIC_RELAXED, __HIP_MEMORY_SCOPE_AGENT); }
__device__ __forceinline__ unsigned xb_xcc_id() { return (unsigned)__builtin_amdgcn_s_getreg((3 << 11) | 20) & 0xFu; }
#define XB_SPIN(cond, bar) do { unsigned _sp = 0; while (cond) { __builtin_amdgcn_s_sleep(1); \
    if ((++_sp & 255u) == 0u) { if (xb_ld(&(bar)[XB_TMO])) break; if (_sp > XB_SPIN_CAP) { atomicAdd(&(bar)[XB_TMO], 1u); break; } } } } while (0)

struct XcdBarrier {
    unsigned* bar; unsigned x;
    volatile LAS unsigned* st;
};

__device__ __forceinline__ XcdBarrier xcd_barrier_post(unsigned* bar, volatile LAS unsigned* st) {
    XcdBarrier b; b.bar = bar; b.x = xb_xcc_id(); b.st = st;
    if (threadIdx.x == 0) (void)xb_add(&bar[XB_XCNT(b.x)], 1u);
    return b;
}
__device__ __forceinline__ void xcd_barrier_complete(unsigned* bar, unsigned x, unsigned& nloc, unsigned& nx) {
    const unsigned G = gridDim.x * gridDim.y * gridDim.z;
    unsigned sum, cnt, mine, sp = 0u;
    for (;;) {
        sum = 0u; cnt = 0u; mine = 0u;
#pragma unroll
        for (unsigned j = 0; j < 16; ++j) { const unsigned c = xb_ld(&bar[XB_XCNT(j)]); sum += c; cnt += (c > 0u) ? 1u : 0u; mine = (j == x) ? c : mine; }
        if (sum == G) break;
        __builtin_amdgcn_s_sleep(1);
        if ((++sp & 255u) == 0u) { if (xb_ld(&bar[XB_TMO])) break; if (sp > XB_SPIN_CAP) { atomicAdd(&bar[XB_TMO], 1u); break; } }
    }
    nloc = mine > 0u ? mine : 1u; nx = cnt > 0u ? cnt : 1u;
}

__device__ __forceinline__ void xcd_barrier(const XcdBarrier& b) {
    asm volatile("s_waitcnt vmcnt(0)" ::: "memory");
    __syncthreads();
    if (threadIdx.x == 0) {
        unsigned* bar = b.bar;
        __builtin_amdgcn_s_waitcnt(0);
        unsigned nloc = b.st[0], nx = b.st[1];
        if (nloc == 0u) { xcd_barrier_complete(bar, b.x, nloc, nx); b.st[0] = nloc; b.st[1] = nx; }
        const unsigned old = xb_add(&bar[XB_XSUB(b.x)], 1u);
        const unsigned gen = old / nloc;
        if (old + 1u == (gen + 1u) * nloc) {
            __builtin_amdgcn_fence(__ATOMIC_RELEASE, "agent");
            asm volatile("s_waitcnt vmcnt(0)" ::: "memory");
            const unsigned og = xb_add(&bar[XB_TOP], 1u);
            const unsigned tg = og / nx;
            if (og + 1u == (tg + 1u) * nx) xb_add(&bar[XB_TOPGEN], 1u);
            else XB_SPIN(xb_ld(&bar[XB_TOPGEN]) == tg, bar);
            __builtin_amdgcn_fence(__ATOMIC_ACQUIRE, "agent");
            xb_add(&bar[XB_XGEN(b.x)], 1u);
            asm volatile("s_waitcnt vmcnt(0)" ::: "memory");
        } else {
            XB_SPIN(xb_ld(&bar[XB_XGEN(b.x)]) == gen, bar);
            __builtin_amdgcn_fence(__ATOMIC_ACQUIRE, "agent");
            asm volatile("s_waitcnt vmcnt(0)" ::: "memory");
        }
    }
    __syncthreads();
}

#define DI __device__ __forceinline__
typedef float f32x16 __attribute__((ext_vector_type(16)));
typedef unsigned u32x2 __attribute__((ext_vector_type(2)));
typedef float f32x2v __attribute__((ext_vector_type(2)));
typedef __bf16 bf16x2_t __attribute__((ext_vector_type(2)));
#define MFMA32(a, b, c) __builtin_amdgcn_mfma_f32_32x32x16_bf16((a), (b), (c), 0, 0, 0)
#define MFMA16(a, b, c) __builtin_amdgcn_mfma_f32_16x16x32_bf16((a), (b), (c), 0, 0, 0)

DI unsigned cvtpk(float lo, float hi) { f32x2v v = {lo, hi}; bf16x2_t b = __builtin_convertvector(v, bf16x2_t); return __builtin_bit_cast(unsigned, b); }
DI float bf_lo(unsigned w) { return __uint_as_float(w << 16); }
DI float bf_hi(unsigned w) { return __uint_as_float(w & 0xffff0000u); }
DI float sigmoid_f(float x) { return __builtin_amdgcn_rcpf(1.f + __expf(-x)); }
DI float silu_f(float x) { return x * __builtin_amdgcn_rcpf(1.f + __expf(-x)); }
DI float wave_sum(float v) {
#pragma unroll
    for (int o = 1; o < 64; o <<= 1) v += __shfl_xor(v, o);
    return v;
}
DI float wave_max(float v) {
#pragma unroll
    for (int o = 1; o < 64; o <<= 1) v = fmaxf(v, __shfl_xor(v, o));
    return v;
}
DI int crow(int r, int hi) { return (r & 3) + 8 * (r >> 2) + 4 * hi; }
DI bf16x8 pack8(const f32x16& x, int s) {
    v4u p; p.x = cvtpk(x[8 * s + 0], x[8 * s + 1]); p.y = cvtpk(x[8 * s + 2], x[8 * s + 3]); p.z = cvtpk(x[8 * s + 4], x[8 * s + 5]); p.w = cvtpk(x[8 * s + 6], x[8 * s + 7]);
    return __builtin_bit_cast(bf16x8, p);
}

constexpr int DM = 1024, NB = 8, SEQ = 2048, MP = NB * SEQ, DB = 128, DS = 8, MS = DB * DS, MT = MP + MS;
constexpr int NPROJ = 8192, INCOLS = 8200, NMEMTOK = 256, MMEM = NB * NMEMTOK;
constexpr int PC_Q = 0, PC_K = 1024, PC_V = 2048, PC_O = 3072, PC_Z = 4096, PC_BG = 5120, PC_CG = 5632, PC_XC = 6144, PC_ZCV = 6656, PC_QX = 7168, PC_ZX = 7680;
constexpr int YC_ML = 0, YC_CV = 1024, YC_XA = 1536, NMIX = 2048;
constexpr float EPS = 1e-6f;
constexpr size_t O_YP = 0, O_YS = (size_t)MP * DM, O_CP = O_YS + (size_t)MS * DM, O_NP = O_CP + (size_t)NB * 4 * 65536, O_MP = O_NP + NB * 4 * 256, O_CVP = O_MP + NB * 4,
                 O_MK = O_CVP + NB * 2 * 512, O_MV = O_MK + (size_t)MMEM * 512, O_CS = O_MV + (size_t)MMEM * 512, O_NS = O_CS + (size_t)DB * 4 * 65536, O_MS = O_NS + DB * 4 * 256,
                 O_CVS = O_MS + DB * 4, O_END = O_CVS + DB * 2 * 512;
static_assert(O_END == 55853600, "d_out map");
constexpr size_t MiB = 1u << 20;
constexpr size_t WS_CTL = 0, CTL_ZERO_BYTES = 1 * MiB;
constexpr size_t WS_WIN = 2 * MiB, WS_WOUT = 18 * MiB, WS_WKV = 22 * MiB, WS_MEMN = 24 * MiB, WS_KMEM = 28 * MiB, WS_VT = 30 * MiB, WS_GATES = 32 * MiB, WS_XN = 34 * MiB, WS_YMIX = 68 * MiB,
                 WS_PROJ = 136 * MiB, WS_SSQ = 408 * MiB, WS_SLAB = 412 * MiB, WS_END = 428 * MiB;
static_assert(WS_XN + (size_t)MT * DM * 2 <= WS_YMIX && WS_YMIX + (size_t)MT * NMIX * 2 <= WS_PROJ && WS_PROJ + (size_t)MT * NPROJ * 2 <= WS_SSQ && WS_SSQ + (size_t)MP * 4 * 16 * 4 <= WS_END, "d_ws map");
constexpr int CW_BAR = 4096, CW_QHEAD = 32768;
constexpr int LDS_BYTES = 147456, MISC_OFF = LDS_BYTES - 256;

DI void p0_transpose_item(const float* W, int ldw, int srccol, int k0, bf16* WT, int K, int dstrow, float scale, LAS float* scr, int lane) {
#pragma unroll 8
    for (int i = 0; i < 32; ++i) { const int kk = 2 * i + (lane >> 5); scr[kk * 33 + (lane & 31)] = W[(size_t)(k0 + kk) * ldw + srccol + (lane & 31)]; }
    LDS_WAIT(); asm volatile("" ::: "memory");
    const int c = lane & 7;
#pragma unroll
    for (int j = 0; j < 4; ++j) { const int n = (lane >> 3) + 8 * j; const LAS float* s = scr + (8 * c) * 33 + n;
        v4u o; o.x = pk2(s[0 * 33] * scale, s[1 * 33] * scale); o.y = pk2(s[2 * 33] * scale, s[3 * 33] * scale); o.z = pk2(s[4 * 33] * scale, s[5 * 33] * scale); o.w = pk2(s[6 * 33] * scale, s[7 * 33] * scale);
        *(GAS v4u*)(WT + (size_t)(dstrow + n) * K + k0 + 8 * c) = o; }
    LDS_WAIT(); asm volatile("" ::: "memory");
}
DI void xn_row(const float* xrow, const float* g, bf16* orow, float* gates_row, const LAS float* gw, const float* b_if, int lane) {
    const f32x4* xr = (const f32x4*)xrow + lane;
    f32x4 v[4]; float s = 0.f;
#pragma unroll
    for (int j = 0; j < 4; ++j) { v[j] = xr[64 * j]; s += (v[j].x * v[j].x + v[j].y * v[j].y) + (v[j].z * v[j].z + v[j].w * v[j].w); }
    const float r = rsqrtf(wave_sum(s) * (1.f / 1024.f) + EPS);
    if (gates_row) {
        float dot[8];
#pragma unroll
        for (int q = 0; q < 8; ++q) { float a = 0.f;
#pragma unroll
            for (int j = 0; j < 4; ++j) { const f32x4 w = *(const LAS f32x4*)(gw + q * 1024 + 256 * j + 4 * lane); a += (v[j].x * w.x + v[j].y * w.y) + (v[j].z * w.z + v[j].w * w.w); }
            dot[q] = wave_sum(a); }
        float mine = dot[0];
#pragma unroll
        for (int q = 1; q < 8; ++q) mine = (lane == q) ? dot[q] : mine;
        if (lane < 8) { float pre = mine * r + b_if[lane];
            if (lane >= 4) pre = (pre >= 0.f) ? -log1pf(expf(-pre)) : (pre - log1pf(expf(pre)));
            gates_row[lane] = pre; }
    }
    const f32x4* g4 = (const f32x4*)g + lane;
    u32x2* o8 = (u32x2*)orow + lane;
#pragma unroll
    for (int j = 0; j < 4; ++j) { const f32x4 gv = g4[64 * j]; u32x2 o; o.x = cvtpk(v[j].x * r * gv.x, v[j].y * r * gv.y); o.y = cvtpk(v[j].z * r * gv.z, v[j].w * r * gv.w); o8[64 * j] = o; }
}

constexpr int SC_Q = 0, SC_K = 32768, SC_CB = 65536, CBP = 528, SC_SM = SC_CB + 32 * CBP, SC_VT = SC_SM + 8192, VTP = 144, VTB = 32 * VTP, SC_SO = SC_VT + 2 * VTB, SC_SZ = SC_SO + 8192, SC_MISC = SC_SZ + 8192, SC_GSET = 1536;
constexpr int SM_WS = SC_MISC, SM_HDMIN = SC_MISC + 256, SM_SCAL = SC_MISC + 512,
              SM_RSP = SC_MISC + 3072, SM_QN = SC_MISC + 3584, SM_HINV = SC_MISC + 3840, SM_N = SC_MISC + 4096;
static_assert(SM_SCAL + 16 <= SC_MISC + SC_GSET && SM_N + 2048 <= MISC_OFF, "scan LDS map");
#define LF(off) (*(LAS float*)(lds + (off)))
#define OPAQUE(x) asm volatile("" : "+v"(x))
#define SCAN_BAR() do { asm volatile("s_waitcnt lgkmcnt(0)" ::: "memory"); __builtin_amdgcn_s_barrier(); asm volatile("" ::: "memory"); } while (0)
typedef short v4i16_t __attribute__((ext_vector_type(4)));
DI int skey(int row) { return ((row & 3) << 2) | ((-(row >> 2)) & 3); }
DI bf16x8 tr_frag(LAS unsigned char* p0, LAS unsigned char* p1) {
    const v4i16_t lo = __builtin_amdgcn_ds_read_tr16_b64_v4i16((LAS v4i16_t*)p0), hi = __builtin_amdgcn_ds_read_tr16_b64_v4i16((LAS v4i16_t*)p1);
    return (bf16x8){lo[0], lo[1], lo[2], lo[3], hi[0], hi[1], hi[2], hi[3]};
}
DI void glds16(const void* gsrc, unsigned lds_dst) { unsigned keep;
    asm volatile("s_mov_b32 %0, m0\n\ts_mov_b32 m0, %2\n\ts_nop 0\n\tglobal_load_lds_dwordx4 %1, off\n\ts_mov_b32 m0, %0" : "=&s"(keep) : "v"(gsrc), "s"(lds_dst) : "memory"); }
DI void dma_tile(LAS unsigned char* lds, int tile_off, const bf16* src  , int w, int lane) {
    const int rsub = lane >> 5, pc = lane & 31; const unsigned lbase = (unsigned)(unsigned long)(lds + tile_off);
#pragma unroll
    for (int i = 0; i < 4; ++i) { const int row = 2 * (4 * w + i) + rsub; const int lc = pc ^ skey(row & 15);
        glds16(src + (size_t)row * NPROJ + lc * 8, (unsigned)__builtin_amdgcn_readfirstlane((int)(lbase + (unsigned)((4 * w + i) * 1024)))); }
}
DI float scan_gates(LAS unsigned char* lds, int set, float gi, float gf, float m_run, int lane) {
    float F = gf;
#pragma unroll
    for (int o = 1; o < 64; o <<= 1) { const float t = __shfl_up(F, o); if (lane >= o) F += t; }
    const float a = gi - F;
    const float G = fmaxf(m_run, wave_max(a));
    const float F63 = __shfl(F, 63);
    const int so = set * SC_GSET;
    LF(SM_WS + so + lane * 4) = __expf(a - G); LF(SM_HDMIN + so + lane * 4) = __expf(-(F + G));
    if (lane == 0) { LF(SM_SCAL + so) = __expf(m_run - G); LF(SM_SCAL + so + 4) = F63 + G; }
    return F63 + G;
}
DI void scan_stage_small(LAS unsigned char* lds, int buf, int set, u32x2 vv, u32x2 ov, u32x2 zv, int tid) {
    const int s = tid >> 3, p8 = tid & 7; const float wsv = LF(SM_WS + set * SC_GSET + s * 4);
    const unsigned a = cvtpk(bf_lo(vv.x) * wsv, bf_hi(vv.x) * wsv), bq = cvtpk(bf_lo(vv.y) * wsv, bf_hi(vv.y) * wsv);
    const int vb = SC_VT + buf * VTB + (4 * p8) * VTP + s * 2;
    *(LAS unsigned short*)(lds + vb) = (unsigned short)(a & 0xffffu); *(LAS unsigned short*)(lds + vb + VTP) = (unsigned short)(a >> 16);
    *(LAS unsigned short*)(lds + vb + 2 * VTP) = (unsigned short)(bq & 0xffffu); *(LAS unsigned short*)(lds + vb + 3 * VTP) = (unsigned short)(bq >> 16);
    *(LAS u32x2*)(lds + SC_SO + buf * 4096 + s * 64 + p8 * 8) = ov; *(LAS u32x2*)(lds + SC_SZ + buf * 4096 + s * 64 + p8 * 8) = zv;
}
DI void scan_job(LAS unsigned char* lds, int bh, int sl, const bf16* PROJ, const float* GATES, bf16* YMIX, float* SSQ, float* outC, float* outN, float* outM, int tid0) {
    const int w = __builtin_amdgcn_readfirstlane(tid0 >> 6);
    const int b = bh >> 2, h = bh & 3;
    const size_t row_base = (size_t)b * SEQ;
    constexpr int NCH = SEQ / 64;
    f32x16 Cacc;
#pragma unroll
    for (int r = 0; r < 16; ++r) Cacc[r] = 0.f;
    float m_run = 0.f;
    if (tid0 < 256) LF(SM_N + tid0 * 4) = 0.f;
    for (int e = tid0; e < 32 * CBP / 4; e += 512) *(LAS unsigned*)(lds + SC_CB + e * 4) = 0u;
    { const int lane = tid0 & 63; const bf16* p = PROJ + row_base * NPROJ + h * 256;
      dma_tile(lds, SC_Q, p + PC_Q, w, lane); dma_tile(lds, SC_K, p + PC_K, w, lane);
      if (w == 0) m_run = scan_gates(lds, 0, GATES[(row_base + lane) * 8 + h], GATES[(row_base + lane) * 8 + 4 + h], 0.f, lane);
      __syncthreads();
      const bf16* ps = PROJ + (row_base + (tid0 >> 3)) * NPROJ + h * 256 + 32 * sl + (tid0 & 7) * 4;
      scan_stage_small(lds, 0, 0, *(const u32x2*)(ps + PC_V), *(const u32x2*)(ps + PC_O), *(const u32x2*)(ps + PC_Z), tid0); }
    asm volatile("s_waitcnt vmcnt(0)" ::: "memory");
    __syncthreads();
    unsigned ypk0 = 0u, ypk1 = 0u; float q2[4] = {0.f, 0.f, 0.f, 0.f};
#pragma unroll 1
    for (int c = 0; c <= NCH; ++c) {
        int tid = tid0; OPAQUE(tid);
        const int lane = tid & 63, hh = lane >> 5, l31 = lane & 31, l15 = lane & 15, lq = lane >> 4;
        const int gq = (lane & 15) >> 2, gp = lane & 3, g1 = (lane >> 4) & 1;
        const int rt = w >> 1, ct = w & 1;
        if (c > 0) { const size_t rp = row_base + (size_t)(c - 1) * 64; const int t0 = 16 * rt + 4 * lq, e = 16 * ct + l15;
            bf16* yp = YMIX + (rp + t0) * NMIX + YC_ML + h * 256 + 32 * sl + e;
            yp[0] = (bf16)(ypk0 & 0xffffu); yp[NMIX] = (bf16)(ypk0 >> 16); yp[2 * NMIX] = (bf16)(ypk1 & 0xffffu); yp[3 * NMIX] = (bf16)(ypk1 >> 16);
            if (l15 == 0) {
#pragma unroll
                for (int j = 0; j < 4; ++j) SSQ[((rp + t0 + j) * 4 + h) * 16 + 2 * sl + ct] = q2[j]; } }
        if (c == NCH) break;
        const size_t r0 = row_base + (size_t)c * 64;
        const int par = c & 1, gs = par * SC_GSET;
        const bool more = (c + 1 < NCH);
        float ngi = 0.f, ngf = 0.f; u32x2 nv = (u32x2){0u, 0u}, no = nv, nz = nv; unsigned pf0 = 0u, pf1 = 0u;
        if (more) { const bf16* ps = PROJ + (r0 + 64 + (tid >> 3)) * NPROJ + h * 256 + 32 * sl + (tid & 7) * 4;
            nv = *(const u32x2*)(ps + PC_V); no = *(const u32x2*)(ps + PC_O); nz = *(const u32x2*)(ps + PC_Z);
            if (w == 0) { ngi = GATES[(r0 + 64 + lane) * 8 + h]; ngf = GATES[(r0 + 64 + lane) * 8 + 4 + h]; } }
        if (c + 2 < NCH) { if (tid < 64) { const int ln = sl * 64 + tid;
                pf0 = *(const unsigned*)(PROJ + (r0 + 128 + (ln >> 3)) * NPROJ + h * 256 + ((ln >> 2) & 1) * 1024 + (ln & 3) * 64); }
            else if (tid < 256) { const int e = tid - 64; const int rr = e / 3, wh = e - 3 * rr;
                pf1 = *(const unsigned*)(PROJ + (r0 + 128 + rr) * NPROJ + h * 256 + 32 * sl + (wh == 0 ? PC_V : (wh == 1 ? PC_O : PC_Z))); } }
        const float wC = LF(SM_SCAL + gs);
        bf16x8 qf[8];
        { const int kq = skey(l15); const int abase = SC_Q + (16 * rt + l15) * 512;
#pragma unroll
          for (int ks = 0; ks < 8; ++ks) qf[ks] = *(const LAS bf16x8*)(lds + abase + (((4 * ks + lq) ^ kq) << 4));
          const int ct0 = ct * 2, bbase = SC_K + (16 * ct0 + l15) * 512;
          f32x4 sacc[2]; sacc[0] = (f32x4){0.f, 0.f, 0.f, 0.f}; sacc[1] = sacc[0];
#pragma unroll
          for (int ks = 0; ks < 8; ++ks)
#pragma unroll
              for (int n = 0; n < 2; ++n) { const bf16x8 bf = *(const LAS bf16x8*)(lds + bbase + n * 16 * 512 + (((4 * ks + lq) ^ kq) << 4)); sacc[n] = MFMA16(qf[ks], bf, sacc[n]); }
          float rs[4] = {0.f, 0.f, 0.f, 0.f};
          const int t0 = 16 * rt + 4 * lq;
#pragma unroll
          for (int n = 0; n < 2; ++n) { const int s = 16 * (ct0 + n) + l15; const float wss = LF(SM_WS + gs + s * 4);
              float v[4];
#pragma unroll
              for (int j = 0; j < 4; ++j) { v[j] = (s <= t0 + j) ? sacc[n][j] : 0.f; rs[j] += v[j] * wss; }
              const unsigned p01 = cvtpk(v[0], v[1]), p23 = cvtpk(v[2], v[3]);
#pragma unroll
              for (int j = 0; j < 4; ++j) { const int t = t0 + j; const unsigned pv = (j < 2) ? p01 : p23;
                  *(LAS unsigned short*)(lds + SC_SM + t * 128 + ((((s >> 3) ^ ((t >> 1) & 7))) << 4) + (s & 7) * 2) = (unsigned short)((j & 1) ? (pv >> 16) : (pv & 0xffffu)); } }
#pragma unroll
          for (int j = 0; j < 4; ++j) { float v = rs[j]; v += __shfl_xor(v, 1); v += __shfl_xor(v, 2); v += __shfl_xor(v, 4); v += __shfl_xor(v, 8);
              if (l15 == 0) LF(SM_RSP + (ct * 64 + t0 + j) * 4) = v; }
        }
        { const int t = tid >> 3, part = tid & 7; float acc = 0.f; const int kt = skey(t & 15);
#pragma unroll
          for (int cc = 0; cc < 4; ++cc) { const int cx = 4 * part + cc; const v4u qv = *(const LAS v4u*)(lds + SC_Q + t * 512 + ((cx ^ kt) << 4));
              const f32x4 n0 = *(const LAS f32x4*)(lds + SM_N + par * 1024 + cx * 32), n1 = *(const LAS f32x4*)(lds + SM_N + par * 1024 + cx * 32 + 16);
              acc += bf_lo(qv.x) * n0.x + bf_hi(qv.x) * n0.y + bf_lo(qv.y) * n0.z + bf_hi(qv.y) * n0.w + bf_lo(qv.z) * n1.x + bf_hi(qv.z) * n1.y + bf_lo(qv.w) * n1.z + bf_hi(qv.w) * n1.w; }
          acc += __shfl_xor(acc, 1); acc += __shfl_xor(acc, 2); acc += __shfl_xor(acc, 4);
          if (part == 0) LF(SM_QN + t * 4) = acc;
        }
        { const int trx = 2 * g1 + (gp >> 1), trk1 = hh ? 2 : 0, trk2 = hh ? 1 : 3, tro = (8 * hh + gq) * 512 + 8 * (gp & 1);
          const int c1 = (((4 * w) ^ (4 * gq)) + (trx ^ trk1)) << 4, c2 = (((4 * w) ^ (4 * gq)) + (trx ^ trk2)) << 4;
          const int vb = SC_VT + par * VTB + l31 * VTP + hh * 16;
#pragma unroll
          for (int r = 0; r < 16; ++r) Cacc[r] *= wC;
#pragma unroll
          for (int ks = 0; ks < 4; ++ks) { const bf16x8 afr = tr_frag(lds + SC_K + ks * 8192 + tro + c1, lds + SC_K + ks * 8192 + tro + 4 * 512 + c2);
              const bf16x8 bfr = *(const LAS bf16x8*)(lds + vb + ks * 32); Cacc = MFMA32(afr, bfr, Cacc); } }
        { bf16x8 wsb[2];
#pragma unroll
          for (int ks = 0; ks < 2; ++ks) { const f32x4 w0 = *(const LAS f32x4*)(lds + SM_WS + gs + (32 * ks + 8 * lq) * 4), w1 = *(const LAS f32x4*)(lds + SM_WS + gs + (32 * ks + 8 * lq) * 4 + 16);
              v4u o; o.x = cvtpk(w0.x, w0.y); o.y = cvtpk(w0.z, w0.w); o.z = cvtpk(w1.x, w1.y); o.w = cvtpk(w1.z, w1.w);
              if (l15 != 0) o = (v4u){0u, 0u, 0u, 0u};
              wsb[ks] = __builtin_bit_cast(bf16x8, o); }
          const int nq = l15 >> 2, np = l15 & 3;
#pragma unroll
          for (int dti = 0; dti < 2; ++dti) { const int dt = 2 * w + dti; f32x4 nacc = (f32x4){0.f, 0.f, 0.f, 0.f};
#pragma unroll
              for (int ks = 0; ks < 2; ++ks) { const int ra = 32 * ks + 8 * lq + nq, rb = ra + 4; const int lc = 2 * dt + (np >> 1);
                  const bf16x8 afr = tr_frag(lds + SC_K + ra * 512 + ((lc ^ skey(ra & 15)) << 4) + 8 * (np & 1), lds + SC_K + rb * 512 + ((lc ^ skey(rb & 15)) << 4) + 8 * (np & 1));
                  nacc = MFMA16(afr, wsb[ks], nacc); }
              if (l15 == 0) {
#pragma unroll
                  for (int j = 0; j < 4; ++j) { const int d = 16 * dt + 4 * lq + j; LF(SM_N + (par ^ 1) * 1024 + d * 4) = wC * LF(SM_N + par * 1024 + d * 4) + nacc[j]; } } } }
        asm volatile("" :: "v"(nv), "v"(no), "v"(nz), "v"(ngi), "v"(ngf), "v"(pf0), "v"(pf1));
        SCAN_BAR();
        if (more) { const bf16* p = PROJ + (r0 + 64) * NPROJ + h * 256; dma_tile(lds, SC_Q, p + PC_Q, w, lane); dma_tile(lds, SC_K, p + PC_K, w, lane); }
        if (tid < 64) { const float rowsum = LF(SM_RSP + tid * 4) + LF(SM_RSP + 256 + tid * 4); const float den = wC * LF(SM_QN + tid * 4) + rowsum;
            LF(SM_HINV + tid * 4) = __builtin_amdgcn_rcpf(fmaxf(fabsf(den), LF(SM_HDMIN + gs + tid * 4))); }
        if (w == 0 && more) m_run = scan_gates(lds, par ^ 1, ngi, ngf, m_run, lane);
        f32x4 num = (f32x4){0.f, 0.f, 0.f, 0.f};
        { const int cb0 = SC_CB + (16 * ct + l15) * CBP + lq * 16;
#pragma unroll
          for (int ks = 0; ks < 8; ++ks) { const bf16x8 bf = *(const LAS bf16x8*)(lds + cb0 + ks * 64); num = MFMA16(qf[ks], bf, num); }
          num = num * wC;
          const int t = 16 * rt + l15; const int sw = (t >> 1) & 7; const int vb = SC_VT + par * VTB + (16 * ct + l15) * VTP + lq * 16;
#pragma unroll
          for (int ks = 0; ks < 2; ++ks) { const bf16x8 af = *(const LAS bf16x8*)(lds + SC_SM + t * 128 + (((4 * ks + lq) ^ sw) << 4)), bf = *(const LAS bf16x8*)(lds + vb + ks * 64); num = MFMA16(af, bf, num); } }
        SCAN_BAR();
        if (more) scan_stage_small(lds, par ^ 1, par ^ 1, nv, no, nz, tid);
#pragma unroll
        for (int g = 0; g < 4; ++g) { u32x2 pk; pk.x = cvtpk(Cacc[4 * g], Cacc[4 * g + 1]); pk.y = cvtpk(Cacc[4 * g + 2], Cacc[4 * g + 3]);
            *(LAS u32x2*)(lds + SC_CB + l31 * CBP + (32 * w + 8 * g + 4 * hh) * 2) = pk; }
        { const int t0 = 16 * rt + 4 * lq, e = 16 * ct + l15;
          float yv[4];
#pragma unroll
          for (int j = 0; j < 4; ++j) { const int t = t0 + j;
              const float so = bf_lo((unsigned)*(const LAS unsigned short*)(lds + SC_SO + par * 4096 + t * 64 + e * 2)), sz = bf_lo((unsigned)*(const LAS unsigned short*)(lds + SC_SZ + par * 4096 + t * 64 + e * 2));
              const float ho = so * num[j] * LF(SM_HINV + t * 4); q2[j] = ho * ho; yv[j] = ho * sz; }
          ypk0 = cvtpk(yv[0], yv[1]); ypk1 = cvtpk(yv[2], yv[3]);
#pragma unroll
          for (int j = 0; j < 4; ++j) { float v = q2[j]; v += __shfl_xor(v, 1); v += __shfl_xor(v, 2); v += __shfl_xor(v, 4); v += __shfl_xor(v, 8); q2[j] = v; }
        }
        asm volatile("s_waitcnt vmcnt(0)" ::: "memory"); SCAN_BAR();
    }
    { const int lane = tid0 & 63, hh = lane >> 5, l31 = lane & 31;
#pragma unroll
      for (int r = 0; r < 16; ++r) outC[((size_t)bh * 256 + 32 * w + crow(r, hh)) * 256 + 32 * sl + l31] = Cacc[r];
      if (sl == 0) { if (tid0 < 256) outN[bh * 256 + tid0] = LF(SM_N + (NCH & 1) * 1024 + tid0 * 4); if (tid0 == 0) outM[bh] = m_run; } }
    __syncthreads();
}

constexpr int AT_K = 0, AT_KP = 272, AT_VT = 69632, AT_VP = 520, AT_SUM = AT_VT + 128 * AT_VP;
static_assert(AT_SUM + 1024 <= MISC_OFF, "attention LDS map");
DI void attn_prompt_unit(LAS unsigned char* lds, int unit, const bf16* PROJ, const bf16* KMEM, const bf16* VT, bf16* YMIX, int tid) {
    const int lane = tid & 63, w = __builtin_amdgcn_readfirstlane(tid >> 6), hh = lane >> 5, l31 = lane & 31;
    const int b = unit >> 5, h = (unit >> 3) & 3, qb = unit & 7;
#pragma unroll
    for (int i = 0; i < 8; ++i) { const int idx = tid + 512 * i; const int key = idx >> 4, cx = idx & 15;
        const v4u v = *(const v4u*)(KMEM + (size_t)(b * 256 + key) * 512 + h * 128 + cx * 8); *(LAS v4u*)(lds + AT_K + key * AT_KP + cx * 16) = v; }
#pragma unroll
    for (int i = 0; i < 8; ++i) { const int idx = tid + 512 * i; const int d = idx >> 5, cx = idx & 31;
        const v4u v = *(const v4u*)(VT + (size_t)(h * 128 + d) * 2048 + b * 256 + cx * 8);
        u32x2 a, c; a.x = v.x; a.y = v.y; c.x = v.z; c.y = v.w;
        *(LAS u32x2*)(lds + AT_VT + d * AT_VP + cx * 16) = a; *(LAS u32x2*)(lds + AT_VT + d * AT_VP + cx * 16 + 8) = c; }
    __syncthreads();
    const size_t row0 = (size_t)b * SEQ + qb * 256 + 32 * w;
    const float c2 = 0.08838834764831845f * 1.4426950408889634f;
    float m_run = -3.0e38f, l_run = 0.f;
    f32x16 O[4];
#pragma unroll
    for (int dt = 0; dt < 4; ++dt)
#pragma unroll
        for (int r = 0; r < 16; ++r) O[dt][r] = 0.f;
    const bf16* qp = PROJ + (row0 + l31) * NPROJ + PC_QX + h * 128 + 8 * hh;
    const int kb0 = AT_K + l31 * AT_KP + hh * 16, vb0 = AT_VT + l31 * AT_VP + hh * 8;
#pragma unroll
    for (int half = 0; half < 2; ++half) {
        f32x16 acc[4];
#pragma unroll
        for (int kt = 0; kt < 4; ++kt)
#pragma unroll
            for (int r = 0; r < 16; ++r) acc[kt][r] = 0.f;
#pragma unroll
        for (int kh = 0; kh < 2; ++kh) {
            bf16x8 qf[4];
#pragma unroll
            for (int k4 = 0; k4 < 4; ++k4) qf[k4] = *(const bf16x8*)(qp + 16 * (4 * kh + k4));
#pragma unroll
            for (int k4 = 0; k4 < 4; ++k4)
#pragma unroll
                for (int kt = 0; kt < 4; ++kt) { const bf16x8 af = *(const LAS bf16x8*)(lds + kb0 + (4 * half + kt) * 32 * AT_KP + (4 * kh + k4) * 32); acc[kt] = MFMA32(af, qf[k4], acc[kt]); } }
        float mx = m_run;
#pragma unroll
        for (int kt = 0; kt < 4; ++kt)
#pragma unroll
            for (int r = 0; r < 16; ++r) mx = fmaxf(mx, acc[kt][r]);
        mx = fmaxf(mx, __shfl_xor(mx, 32));
        const float alpha = __builtin_amdgcn_exp2f((m_run - mx) * c2);
        m_run = mx;
        float sum = 0.f;
        bf16x8 pk[4][2];
#pragma unroll
        for (int kt = 0; kt < 4; ++kt) {
#pragma unroll
            for (int r = 0; r < 16; ++r) { const float p = __builtin_amdgcn_exp2f((acc[kt][r] - mx) * c2); acc[kt][r] = p; sum += p; }
            pk[kt][0] = pack8(acc[kt], 0); pk[kt][1] = pack8(acc[kt], 1); }
        sum += __shfl_xor(sum, 32);
        l_run = l_run * alpha + sum;
        if (half == 1) {
            __syncthreads();
            if (hh == 0) LF(AT_SUM + (w * 32 + l31) * 4) = alpha;
#pragma unroll
            for (int r = 0; r < 16; ++r) { const float al = LF(AT_SUM + (w * 32 + crow(r, hh)) * 4);
#pragma unroll
                for (int dt = 0; dt < 4; ++dt) O[dt][r] *= al; }
        }
#pragma unroll
        for (int kt = 0; kt < 4; ++kt)
#pragma unroll
            for (int s2 = 0; s2 < 2; ++s2)
#pragma unroll
                for (int dt = 0; dt < 4; ++dt) { const int o = vb0 + dt * 32 * AT_VP + (8 * (4 * half + kt) + 4 * s2) * 8;
                    const u32x2 lo = *(const LAS u32x2*)(lds + o), hi = *(const LAS u32x2*)(lds + o + 16);
                    v4u bv; bv.x = lo.x; bv.y = lo.y; bv.z = hi.x; bv.w = hi.y;
                    O[dt] = MFMA32(pk[kt][s2], __builtin_bit_cast(bf16x8, bv), O[dt]); }
    }
    asm volatile("s_waitcnt lgkmcnt(0)" ::: "memory");
    if (hh == 0) LF(AT_SUM + (w * 32 + l31) * 4) = l_run;
    { const int stg = AT_K + w * (32 * 264);
#pragma unroll
      for (int r = 0; r < 16; ++r) { const int q = crow(r, hh); const float inv = 1.f / LF(AT_SUM + (w * 32 + q) * 4);
#pragma unroll
        for (int dt = 0; dt < 4; ++dt) *(LAS unsigned short*)(lds + stg + q * 264 + (32 * dt + l31) * 2) = (unsigned short)f2bf(O[dt][r] * inv); }
#pragma unroll
      for (int i = 0; i < 8; ++i) { const int q = 4 * i + (lane >> 4), cx = lane & 15; const size_t row = row0 + q;
        const u32x2 oa = *(const LAS u32x2*)(lds + stg + q * 264 + cx * 16), ob = *(const LAS u32x2*)(lds + stg + q * 264 + cx * 16 + 8);
        const v4u zv = *(const v4u*)(PROJ + row * NPROJ + PC_ZX + h * 128 + cx * 8);
        v4u y; y.x = cvtpk(bf_lo(oa.x) * bf_lo(zv.x), bf_hi(oa.x) * bf_hi(zv.x)); y.y = cvtpk(bf_lo(oa.y) * bf_lo(zv.y), bf_hi(oa.y) * bf_hi(zv.y));
        y.z = cvtpk(bf_lo(ob.x) * bf_lo(zv.z), bf_hi(ob.x) * bf_hi(zv.z)); y.w = cvtpk(bf_lo(ob.y) * bf_lo(zv.w), bf_hi(ob.y) * bf_hi(zv.w));
        *(v4u*)(YMIX + row * NMIX + YC_XA + h * 128 + cx * 8) = y; } }
    __syncthreads();
}

constexpr int SS_QT = 0, SS_K = 8192, SS_V = 16384, SS_KWT = 24576, SS_QC = 32768;
DI void smlstm_unit(LAS unsigned char* lds, int bh, const bf16* PROJ, const float* GATES, const float* C0, const float* n0, const float* m0p, const float* g_head, bf16* YMIX,
                    float* outC, float* outN, float* outM, int tid) {
    const int lane = tid & 63, w = __builtin_amdgcn_readfirstlane(tid >> 6);
    const int b = bh >> 2, h = bh & 3;
    const size_t rowb = (size_t)MP + (size_t)b * 8;
    f32x4 q4, k4;
    { const bf16* p = PROJ + (rowb + w) * NPROJ + h * 256 + 4 * lane;
      const u32x2 qv = *(const u32x2*)(p + PC_Q), kv = *(const u32x2*)(p + PC_K), vv = *(const u32x2*)(p + PC_V);
      q4 = (f32x4){bf_lo(qv.x), bf_hi(qv.x), bf_lo(qv.y), bf_hi(qv.y)}; k4 = (f32x4){bf_lo(kv.x), bf_hi(kv.x), bf_lo(kv.y), bf_hi(kv.y)};
      const f32x4 v4 = (f32x4){bf_lo(vv.x), bf_hi(vv.x), bf_lo(vv.y), bf_hi(vv.y)};
      *(LAS f32x4*)(lds + SS_K + (w * 256 + 4 * lane) * 4) = k4; *(LAS f32x4*)(lds + SS_V + (w * 256 + 4 * lane) * 4) = v4;
#pragma unroll
      for (int i = 0; i < 4; ++i) LF(SS_QT + ((4 * lane + i) * 8 + w) * 4) = q4[i];
      *(LAS f32x4*)(lds + SS_QC + (w * 256 + 4 * lane) * 4) = (f32x4){0.f, 0.f, 0.f, 0.f}; }
    const float m0 = m0p[bh];
    float F[8], a[8], g[8], wsv[8];
    { float run = 0.f, cm = 0.f;
#pragma unroll
      for (int s = 0; s < 8; ++s) { const float gi = GATES[(rowb + s) * 8 + h], gf = GATES[(rowb + s) * 8 + 4 + h]; run += gf; F[s] = run; a[s] = gi - run; cm = (s == 0) ? a[0] : fmaxf(cm, a[s]); g[s] = fmaxf(m0, cm); } }
    const float g7 = g[7], wC = __expf(m0 - g7), m_new = F[7] + g7;
#pragma unroll
    for (int s = 0; s < 8; ++s) wsv[s] = __expf(a[s] - g7);
    float st[8], winter_t, hinv_t;
    { float gt = g[0], Ft = F[0], wsw = wsv[0];
#pragma unroll
      for (int s = 1; s < 8; ++s) { gt = (w == s) ? g[s] : gt; Ft = (w == s) ? F[s] : Ft; wsw = (w == s) ? wsv[s] : wsw; }
#pragma unroll
      for (int i = 0; i < 4; ++i) LF(SS_KWT + ((4 * lane + i) * 8 + w) * 4) = k4[i] * wsw;
      __syncthreads();
      float part[8];
#pragma unroll
      for (int s = 0; s < 8; ++s) { const f32x4 ks = *(const LAS f32x4*)(lds + SS_K + (s * 256 + 4 * lane) * 4); part[s] = wave_sum((q4.x * ks.x + q4.y * ks.y) + (q4.z * ks.z + q4.w * ks.w)); }
      const f32x4 n4 = *(const f32x4*)(n0 + (size_t)bh * 256 + 4 * lane);
      const float pn = wave_sum((q4.x * n4.x + q4.y * n4.y) + (q4.z * n4.z + q4.w * n4.w));
      float rowsum = 0.f;
#pragma unroll
      for (int s = 0; s < 8; ++s) { const float dcy = (s <= w) ? __expf(a[s] - gt) : 0.f; st[s] = part[s] * dcy; rowsum += st[s]; }
      winter_t = __expf(m0 - gt);
      const float den = winter_t * pn + rowsum;
      hinv_t = 1.f / fmaxf(fabsf(den), __expf(-(Ft + gt)));
    }
    f32x4 v4[8];
#pragma unroll
    for (int s = 0; s < 8; ++s) v4[s] = *(const LAS f32x4*)(lds + SS_V + (s * 256 + 4 * lane) * 4);
    f32x4 acc[8];
#pragma unroll
    for (int t = 0; t < 8; ++t) acc[t] = (f32x4){0.f, 0.f, 0.f, 0.f};
    const float* Cp = C0 + (size_t)bh * 65536 + 4 * lane; float* Co = outC + (size_t)bh * 65536 + 4 * lane;
#pragma unroll 1
    for (int rb = 0; rb < 32; rb += 16) {
      f32x4 cbuf[16];
#pragma unroll
      for (int r = 0; r < 16; ++r) cbuf[r] = __builtin_nontemporal_load((const f32x4*)(Cp + (size_t)(w + 8 * (rb + r)) * 256));
#pragma unroll
      for (int rr = 0; rr < 16; ++rr) { const int d = w + 8 * (rb + rr);
        const f32x4 c4 = cbuf[rr];
        const f32x4 qa = *(const LAS f32x4*)(lds + SS_QT + d * 32), qb = *(const LAS f32x4*)(lds + SS_QT + d * 32 + 16);
        const f32x4 ka = *(const LAS f32x4*)(lds + SS_KWT + d * 32), kb = *(const LAS f32x4*)(lds + SS_KWT + d * 32 + 16);
        acc[0] += qa.x * c4; acc[1] += qa.y * c4; acc[2] += qa.z * c4; acc[3] += qa.w * c4; acc[4] += qb.x * c4; acc[5] += qb.y * c4; acc[6] += qb.z * c4; acc[7] += qb.w * c4;
        f32x4 cn = c4 * wC;
        cn += ka.x * v4[0]; cn += ka.y * v4[1]; cn += ka.z * v4[2]; cn += ka.w * v4[3]; cn += kb.x * v4[4]; cn += kb.y * v4[5]; cn += kb.z * v4[6]; cn += kb.w * v4[7];
        __builtin_nontemporal_store(cn, (f32x4*)(Co + (size_t)d * 256)); } }
#pragma unroll
    for (int t = 0; t < 8; ++t)
#pragma unroll
        for (int i = 0; i < 4; ++i) __hip_atomic_fetch_add((LAS float*)(lds + SS_QC + (t * 256 + 4 * lane + i) * 4), acc[t][i], __ATOMIC_RELAXED, __HIP_MEMORY_SCOPE_WORKGROUP);
    if (tid < 256) { const int d = tid; const f32x4 ka = *(const LAS f32x4*)(lds + SS_KWT + d * 32), kb = *(const LAS f32x4*)(lds + SS_KWT + d * 32 + 16);
        outN[(size_t)bh * 256 + d] = wC * n0[(size_t)bh * 256 + d] + ((ka.x + ka.y) + (ka.z + ka.w)) + ((kb.x + kb.y) + (kb.z + kb.w)); }
    if (tid == 0) outM[bh] = m_new;
    __syncthreads();
    { const f32x4 qc = *(const LAS f32x4*)(lds + SS_QC + (w * 256 + 4 * lane) * 4);
      f32x4 num = qc * winter_t;
#pragma unroll
      for (int s = 0; s < 8; ++s) num += st[s] * v4[s];
      const f32x4 hv = num * hinv_t;
      const size_t row = rowb + w;
      const u32x2 ov = *(const u32x2*)(PROJ + row * NPROJ + PC_O + h * 256 + 4 * lane), zv = *(const u32x2*)(PROJ + row * NPROJ + PC_Z + h * 256 + 4 * lane);
      const f32x4 ho = (f32x4){bf_lo(ov.x) * hv.x, bf_hi(ov.x) * hv.y, bf_lo(ov.y) * hv.z, bf_hi(ov.y) * hv.w};
      const float ssq = wave_sum((ho.x * ho.x + ho.y * ho.y) + (ho.z * ho.z + ho.w * ho.w));
      const float rr = rsqrtf(ssq * (1.f / 256.f) + EPS);
      u32x2 o; o.x = cvtpk(ho.x * rr * bf_lo(zv.x), ho.y * rr * bf_hi(zv.x)); o.y = cvtpk(ho.z * rr * bf_lo(zv.y), ho.w * rr * bf_hi(zv.y));
      *(u32x2*)(YMIX + row * NMIX + YC_ML + h * 256 + 4 * lane) = o; }
    __syncthreads();
}

constexpr int SA_Q = 0, SA_S = 4096, SA_K = 16384, SA_PART = 86016;
DI void sattn_unit(LAS unsigned char* lds, int bh, const bf16* PROJ, const float* ck, const float* cv, bf16* YMIX, int tid) {
    const int lane = tid & 63, w = __builtin_amdgcn_readfirstlane(tid >> 6);
    const int b = bh >> 2, h = bh & 3;
    const size_t rowb = (size_t)MP + (size_t)b * 8;
    if (tid < 256) { const int t = tid >> 5, d = (tid & 31) * 4; const u32x2 qv = *(const u32x2*)(PROJ + (rowb + t) * NPROJ + PC_QX + h * 128 + d);
        *(LAS f32x4*)(lds + SA_Q + (t * 128 + d) * 4) = (f32x4){bf_lo(qv.x), bf_hi(qv.x), bf_lo(qv.y), bf_hi(qv.y)}; }
#pragma unroll 1
    for (int half = 0; half < 2; ++half) {
#pragma unroll
        for (int i = 0; i < 8; ++i) { const int idx = tid + 512 * i; const int key = idx >> 5, c4 = idx & 31;
            const f32x4 v = __builtin_nontemporal_load((const f32x4*)(ck + ((size_t)(b * 256 + half * 128 + key) * 4 + h) * 128 + c4 * 4)); *(LAS f32x4*)(lds + SA_K + key * 528 + c4 * 16) = v; }
        __syncthreads();
        { const int key = tid & 127, tg = tid >> 7; float a0 = 0.f, a1 = 0.f;
#pragma unroll 8
          for (int c4 = 0; c4 < 32; ++c4) { const f32x4 kx = *(const LAS f32x4*)(lds + SA_K + key * 528 + c4 * 16);
              const f32x4 qa = *(const LAS f32x4*)(lds + SA_Q + ((2 * tg) * 128 + 4 * c4) * 4), qb = *(const LAS f32x4*)(lds + SA_Q + ((2 * tg + 1) * 128 + 4 * c4) * 4);
              a0 += (kx.x * qa.x + kx.y * qa.y) + (kx.z * qa.z + kx.w * qa.w); a1 += (kx.x * qb.x + kx.y * qb.y) + (kx.z * qb.z + kx.w * qb.w); }
          LF(SA_S + ((2 * tg) * 256 + half * 128 + key) * 4) = a0 * 0.08838834764831845f; LF(SA_S + ((2 * tg + 1) * 256 + half * 128 + key) * 4) = a1 * 0.08838834764831845f; }
        __syncthreads();
    }
    { f32x4 s4 = *(const LAS f32x4*)(lds + SA_S + (w * 256 + 4 * lane) * 4);
      const float mx = wave_max(fmaxf(fmaxf(s4.x, s4.y), fmaxf(s4.z, s4.w)));
      s4.x = __expf(s4.x - mx); s4.y = __expf(s4.y - mx); s4.z = __expf(s4.z - mx); s4.w = __expf(s4.w - mx);
      const float inv = 1.f / wave_sum((s4.x + s4.y) + (s4.z + s4.w));
      *(LAS f32x4*)(lds + SA_S + (w * 256 + 4 * lane) * 4) = s4 * inv; }
    __syncthreads();
    { const int d4 = (tid & 31) * 4, kg = tid >> 5;
      f32x4 acc[8];
#pragma unroll
      for (int t = 0; t < 8; ++t) acc[t] = (f32x4){0.f, 0.f, 0.f, 0.f};
      const float* vp = cv + ((size_t)(b * 256 + kg * 16) * 4 + h) * 128 + d4;
      f32x4 vb[16];
#pragma unroll
      for (int kk = 0; kk < 16; ++kk) vb[kk] = __builtin_nontemporal_load((const f32x4*)(vp + (size_t)kk * 512));
#pragma unroll
      for (int kk = 0; kk < 16; ++kk) { const int key = kg * 16 + kk;
#pragma unroll
          for (int t = 0; t < 8; ++t) acc[t] += LF(SA_S + (t * 256 + key) * 4) * vb[kk]; }
#pragma unroll
      for (int t = 0; t < 8; ++t) *(LAS f32x4*)(lds + SA_K + ((kg * 8 + t) * 128 + d4) * 4) = acc[t]; }
    __syncthreads();
    { const int t = tid >> 6, d = (tid & 63) * 2; float o0 = 0.f, o1 = 0.f;
#pragma unroll
      for (int kg = 0; kg < 16; ++kg) { const f32x2v p = *(const LAS f32x2v*)(lds + SA_K + ((kg * 8 + t) * 128 + d) * 4); o0 += p.x; o1 += p.y; }
      const size_t row = rowb + t; const unsigned zv = *(const unsigned*)(PROJ + row * NPROJ + PC_ZX + h * 128 + d);
      *(unsigned*)(YMIX + row * NMIX + YC_XA + h * 128 + d) = cvtpk(o0 * bf_lo(zv), o1 * bf_hi(zv)); }
    __syncthreads();
}

DI void conv_token(const bf16* p, const float (&w0)[8], const float (&w1)[8], const float (&w2)[8], const float (&cb)[8], float (&u2)[8], float (&u1)[8], float (&u)[8], bf16* yout) {
    const v4u bg = *(const v4u*)(p + PC_BG), cg = *(const v4u*)(p + PC_CG), xc = *(const v4u*)(p + PC_XC), zc = *(const v4u*)(p + PC_ZCV);
    float y[8];
#pragma unroll
    for (int i = 0; i < 4; ++i) {
        u[2 * i] = bf_lo(cg[i]) * bf_lo(xc[i]); u[2 * i + 1] = bf_hi(cg[i]) * bf_hi(xc[i]);
        const float yc0 = cb[2 * i] + w0[2 * i] * u2[2 * i] + w1[2 * i] * u1[2 * i] + w2[2 * i] * u[2 * i];
        const float yc1 = cb[2 * i + 1] + w0[2 * i + 1] * u2[2 * i + 1] + w1[2 * i + 1] * u1[2 * i + 1] + w2[2 * i + 1] * u[2 * i + 1];
        y[2 * i] = bf_lo(bg[i]) * yc0 * bf_lo(zc[i]); y[2 * i + 1] = bf_hi(bg[i]) * yc1 * bf_hi(zc[i]); }
    v4u o; o.x = cvtpk(y[0], y[1]); o.y = cvtpk(y[2], y[3]); o.z = cvtpk(y[4], y[5]); o.w = cvtpk(y[6], y[7]);
    *(v4u*)yout = o;
}
DI void conv_item(int item, const bf16* PROJ, const float* state_conv, const float* conv_w, const float* conv_b, bf16* YMIX, float* out_cvp, float* out_cvs, int tid) {
    const int c8 = tid & 63, sub = tid >> 6, ch = 8 * c8;
    float w0[8], w1[8], w2[8], cb[8], u2[8], u1[8], u[8];
#pragma unroll
    for (int i = 0; i < 8; ++i) { w0[i] = conv_w[ch + i]; w1[i] = conv_w[512 + ch + i]; w2[i] = conv_w[1024 + ch + i]; cb[i] = conv_b[ch + i]; }
    if (item < 64) {
        const int b = item >> 3, blk = item & 7, t0 = blk * 256 + sub * 32; const size_t rowb = (size_t)b * SEQ;
#pragma unroll
        for (int i = 0; i < 8; ++i) { u2[i] = 0.f; u1[i] = 0.f; }
        if (t0 >= 2) {
            const bf16* pa = PROJ + (rowb + t0 - 2) * NPROJ + ch; const bf16* pb = PROJ + (rowb + t0 - 1) * NPROJ + ch;
            const v4u cga = *(const v4u*)(pa + PC_CG), xca = *(const v4u*)(pa + PC_XC), cgb = *(const v4u*)(pb + PC_CG), xcb = *(const v4u*)(pb + PC_XC);
#pragma unroll
            for (int i = 0; i < 4; ++i) { u2[2 * i] = bf_lo(cga[i]) * bf_lo(xca[i]); u2[2 * i + 1] = bf_hi(cga[i]) * bf_hi(xca[i]); u1[2 * i] = bf_lo(cgb[i]) * bf_lo(xcb[i]); u1[2 * i + 1] = bf_hi(cgb[i]) * bf_hi(xcb[i]); }
        }
#pragma unroll 2
        for (int tt = 0; tt < 32; ++tt) { const int t = t0 + tt; const size_t row = rowb + t;
            conv_token(PROJ + row * NPROJ + ch, w0, w1, w2, cb, u2, u1, u, YMIX + row * NMIX + YC_CV + ch);
            if (t >= SEQ - 2) { float* o = out_cvp + ((size_t)b * 2 + (t - (SEQ - 2))) * 512 + ch; *(f32x4*)o = (f32x4){u[0], u[1], u[2], u[3]}; *(f32x4*)(o + 4) = (f32x4){u[4], u[5], u[6], u[7]}; }
#pragma unroll
            for (int i = 0; i < 8; ++i) { u2[i] = u1[i]; u1[i] = u[i]; } }
    } else {
        const int si = item - 64;
#pragma unroll 1
        for (int q = 0; q < 4; ++q) { const int seq = si * 32 + sub * 4 + q; const size_t rowb = (size_t)MP + (size_t)seq * 8;
#pragma unroll
            for (int i = 0; i < 8; ++i) { u2[i] = state_conv[((size_t)seq * 2 + 0) * 512 + ch + i]; u1[i] = state_conv[((size_t)seq * 2 + 1) * 512 + ch + i]; }
#pragma unroll 2
            for (int t = 0; t < 8; ++t) { const size_t row = rowb + t;
                conv_token(PROJ + row * NPROJ + ch, w0, w1, w2, cb, u2, u1, u, YMIX + row * NMIX + YC_CV + ch);
                if (t >= 6) { float* o = out_cvs + ((size_t)seq * 2 + (t - 6)) * 512 + ch; *(f32x4*)o = (f32x4){u[0], u[1], u[2], u[3]}; *(f32x4*)(o + 4) = (f32x4){u[4], u[5], u[6], u[7]}; }
#pragma unroll
                for (int i = 0; i < 8; ++i) { u2[i] = u1[i]; u1[i] = u[i]; } } }
    }
}
constexpr int IT_SM = 0, IT_SA = 512, IT_SC = 1024, IT_PA = 1028, IT_PC = 1284, NITEMS = 1348;

#ifndef PH_MASK
#define PH_MASK 511
#endif
#ifndef PROBE_REPEAT
#define PROBE_REPEAT -1
#endif
#ifndef PROBE_QSEL
#define PROBE_QSEL 1
#endif
constexpr int N_PHASES = 6;
struct Args { const float* in[19]; float* out; unsigned char* ws; int ph_lo, ph_hi, li, qsel; };
__global__ void __launch_bounds__(512, 2) hyb_fwd(Args args) {
    extern __shared__ __attribute__((aligned(16))) unsigned char lds_raw[];
    LAS unsigned char* lds = (LAS unsigned char*)lds_raw;
    volatile LAS unsigned* MISC = (volatile LAS unsigned*)(lds + MISC_OFF);
    const int tid = threadIdx.x, lane = tid & 63, wave = __builtin_amdgcn_readfirstlane(tid >> 6);
    const int bid = blockIdx.x, G = gridDim.x;
    unsigned char* const ws = args.ws;
    gu32* const ctl = (gu32*)(ws + WS_CTL);
#define xp ((const float*)args.in[0])
#define xs ((const float*)args.in[1])
#define st_C ((const float*)args.in[2])
#define st_n ((const float*)args.in[3])
#define st_m ((const float*)args.in[4])
#define st_conv ((const float*)args.in[5])
#define ck ((const float*)args.in[6])
#define cv ((const float*)args.in[7])
#define memp ((const float*)args.in[8])
#define g_norm ((const float*)args.in[9])
#define w_in ((const float*)args.in[10])
#define b_if ((const float*)args.in[11])
#define g_head ((const float*)args.in[12])
#define conv_w ((const float*)args.in[13])
#define conv_b ((const float*)args.in[14])
#define g_mem ((const float*)args.in[15])
#define w_kv ((const float*)args.in[16])
#define w_out ((const float*)args.in[17])
#define g_final ((const float*)args.in[18])
#define out (args.out)
#define Wt_in ((bf16*)(ws + WS_WIN))
#define Wt_out ((bf16*)(ws + WS_WOUT))
#define Wt_kv ((bf16*)(ws + WS_WKV))
#define MEMN ((bf16*)(ws + WS_MEMN))
#define KMEM ((bf16*)(ws + WS_KMEM))
#define VT ((bf16*)(ws + WS_VT))
#define GATES ((float*)(ws + WS_GATES))
#define XN ((bf16*)(ws + WS_XN))
#define YMIX ((bf16*)(ws + WS_YMIX))
#define PROJ ((bf16*)(ws + WS_PROJ))
    if (tid < 64) MISC[tid] = 0u;
    __syncthreads();
    XcdBarrier bar = xcd_barrier_post((unsigned*)(ctl + CW_BAR) + args.li * XCD_BAR_WORDS, MISC + 8);
    const int lo = args.ph_lo, hi = args.ph_hi;
#define IN(k) (lo <= (k) && (k) < hi)
#define BOTH(k) (IN(k) && IN((k) + 1))
    const int gw = bid * 8 + wave, NGW = G * 8;

    if ((PH_MASK & 1) && IN(0)) {
        LAS float* scr = (LAS float*)(lds + wave * 16384);
        constexpr int I_IN = 16 * 256, I_OUT = 32 * 32, I_KV = 16 * 32, NIT = I_IN + I_OUT + I_KV;
        for (int it = gw; it < NIT; it += NGW) {
            int r = it;
            if (r < I_IN) { const int kb = r >> 8, nb = r & 255, dstrow = 32 * nb; const int srccol = dstrow + (dstrow >= 5120 ? 8 : 0); const float sc = (dstrow >= 1024 && dstrow < 2048) ? 0.0625f : 1.f;
                p0_transpose_item(w_in, INCOLS, srccol, 64 * kb, Wt_in, 1024, dstrow, sc, scr, lane); continue; }
            r -= I_IN;
            if (r < I_OUT) { const int kb = r >> 5, nb = r & 31; p0_transpose_item(w_out, 1024, 32 * nb, 64 * kb, Wt_out, 2048, 32 * nb, 1.f, scr, lane); continue; }
            r -= I_OUT;
            { const int kb = r >> 5, nb = r & 31; p0_transpose_item(w_kv, 1024, 32 * nb, 64 * kb, Wt_kv, 1024, 32 * nb, 1.f, scr, lane); }
        }
        __syncthreads();
        LAS float* gwl = (LAS float*)lds;
        for (int e = tid; e < 8192; e += 512) { const int q = e >> 10, k = e & 1023; gwl[e] = g_norm[k] * w_in[(size_t)k * INCOLS + 5120 + q]; }
        __syncthreads();
        for (int m = gw; m < MT; m += NGW) { const float* xrow = (m < MP) ? xp + (size_t)m * DM : xs + (size_t)(m - MP) * DM; xn_row(xrow, g_norm, XN + (size_t)m * DM, GATES + (size_t)m * 8, gwl, b_if, lane); }
        for (int m = gw; m < MMEM; m += NGW) xn_row(memp + (size_t)m * DM, g_mem, MEMN + (size_t)m * DM, nullptr, gwl, b_if, lane);
        if (BOTH(0)) xcd_barrier(bar);
    }
    if ((PH_MASK & 2) && IN(1)) {
        { pg8::Gemm g{XN, Wt_in, MT, NPROJ, DM, DM}; pg8::StaticOrder S; S.init(MT, NPROJ, G, bid); pg8::EpiBf16Plain E{PROJ, NPROJ, 1, g_head};
          pg8::gemm_phase<pg8::EpiBf16Plain, pg8::StaticOrder, true, true>(lds, g, S, E); }
        if (bid >= 128 && bid < 160) { pg8::Gemm g{MEMN, Wt_kv, MMEM, 1024, DM, DM}; pg8::StaticOrder S; S.init(MMEM, 1024, 32, bid - 128); pg8::EpiKV E{out + O_MK, out + O_MV, KMEM};
          pg8::gemm_phase<pg8::EpiKV, pg8::StaticOrder, true, true>(lds, g, S, E); }
        if (bid >= 160 && bid < 176) { pg8::Gemm g{Wt_kv + (size_t)512 * DM, MEMN, 512, MMEM, DM, DM}; pg8::StaticOrder S; S.init(512, MMEM, 16, bid - 160); pg8::EpiBf16Plain E{VT, MMEM, 0, nullptr};
          pg8::gemm_phase<pg8::EpiBf16Plain, pg8::StaticOrder, true, true>(lds, g, S, E); }
        if (BOTH(1)) xcd_barrier(bar);
    }
    if (IN(2)) {
        __syncthreads();
        if ((PH_MASK & 4) && args.qsel != 3) scan_job(lds, 4 * (bid & 7) + (bid >> 6), (bid >> 3) & 7, PROJ, GATES, YMIX, (float*)(ws + WS_SSQ), out + O_CP, out + O_NP, out + O_MP, tid);
        for (; args.qsel != 2;) {
            if (tid == 0) MISC[4] = __hip_atomic_fetch_add(ctl + CW_QHEAD + 64 * (args.qsel & 1), 1u, RLX_AGENT);
            __syncthreads();
            const int it = (int)MISC[4];
            __syncthreads();
            if (it >= NITEMS) break;
            int tid = threadIdx.x; OPAQUE(tid);
            if (it < IT_SA) { if (PH_MASK & 8) smlstm_unit(lds, it - IT_SM, PROJ, GATES, st_C, st_n, st_m, g_head, YMIX, out + O_CS, out + O_NS, out + O_MS, tid); }
            else if (it < IT_SC) { if (PH_MASK & 16) sattn_unit(lds, it - IT_SA, PROJ, ck, cv, YMIX, tid); }
            else if (it < IT_PA) { if (PH_MASK & 32) conv_item(64 + (it - IT_SC), PROJ, st_conv, conv_w, conv_b, YMIX, out + O_CVP, out + O_CVS, tid); }
            else if (it < IT_PC) { if (PH_MASK & 64) attn_prompt_unit(lds, it - IT_PA, PROJ, KMEM, VT, YMIX, tid); }
            else { if (PH_MASK & 32) conv_item(it - IT_PC, PROJ, st_conv, conv_w, conv_b, YMIX, out + O_CVP, out + O_CVS, tid); }
        }
        if (BOTH(2)) xcd_barrier(bar);
    }
    if (IN(3)) {
        const float* SSQ = (const float*)(ws + WS_SSQ);
        for (int u = gw; u < MP * 4; u += NGW) { const float part = (lane < 16) ? SSQ[(size_t)u * 16 + lane] : 0.f;
            const float rr = rsqrtf(wave_sum(part) * (1.f / 256.f) + EPS);
            u32x2* yp = (u32x2*)(YMIX + (size_t)(u >> 2) * NMIX + YC_ML + (u & 3) * 256) + lane; const u32x2 v = *yp;
            u32x2 o; o.x = cvtpk(bf_lo(v.x) * rr, bf_hi(v.x) * rr); o.y = cvtpk(bf_lo(v.y) * rr, bf_hi(v.y) * rr); *yp = o; }
        if (BOTH(3)) xcd_barrier(bar);
    }
    if ((PH_MASK & 128) && IN(4)) {
        __syncthreads();
        { pg8::Gemm g{YMIX, Wt_out, MP, DM, NMIX, NMIX}; pg8::StaticOrder S; S.init(MP, DM, G, bid); pg8::EpiOut E{xp, xs, MP, out + O_YP};
          pg8::gemm_phase<pg8::EpiOut, pg8::StaticOrder, true, true>(lds, g, S, E); }
        if (bid < 64) { const int sp = bid >> 4;
          pg8::Gemm g{YMIX + (size_t)MP * NMIX + sp * 512, Wt_out + sp * 512, MS, DM, 512, NMIX}; pg8::StaticOrder S; S.init(MS, DM, 16, bid & 15);
          pg8::EpiSlab E{(float*)(ws + WS_SLAB) + (size_t)sp * MS * DM};
          pg8::gemm_phase<pg8::EpiSlab, pg8::StaticOrder, true, true>(lds, g, S, E); }
        if (BOTH(4)) xcd_barrier(bar);
    }
    if ((PH_MASK & 256) && IN(5)) {
        for (int m = gw; m < MT; m += NGW) { f32x4* row = (f32x4*)(out + O_YP + (size_t)m * DM) + lane; f32x4 v[4]; float s = 0.f;
#pragma unroll
            for (int j = 0; j < 4; ++j) {
                if (m < MP) v[j] = row[64 * j];
                else { const size_t o = (size_t)(m - MP) * DM / 4 + 64 * j + lane; const f32x4* sl = (const f32x4*)(ws + WS_SLAB);
                    v[j] = ((const f32x4*)xs)[o] + ((sl[o] + sl[o + (size_t)MS * DM / 4]) + (sl[o + (size_t)2 * MS * DM / 4] + sl[o + (size_t)3 * MS * DM / 4])); }
                s += (v[j].x * v[j].x + v[j].y * v[j].y) + (v[j].z * v[j].z + v[j].w * v[j].w); }
            const float r = rsqrtf(wave_sum(s) * (1.f / 1024.f) + EPS);
#pragma unroll
            for (int j = 0; j < 4; ++j) { const f32x4 gv = ((const f32x4*)g_final)[64 * j + lane]; row[64 * j] = v[j] * r * gv; } }
    }
#undef IN
#undef BOTH
}
#undef xp
#undef xs
#undef st_C
#undef st_n
#undef st_m
#undef st_conv
#undef ck
#undef cv
#undef memp
#undef g_norm
#undef w_in
#undef b_if
#undef g_head
#undef conv_w
#undef conv_b
#undef g_mem
#undef w_kv
#undef w_out
#undef g_final
#undef out
#undef Wt_in
#undef Wt_out
#undef Wt_kv
#undef MEMN
#undef KMEM
#undef VT
#undef GATES
#undef XN
#undef YMIX
#undef PROJ

extern "C" void kernel_launch(void* const* d_in, const int* in_sizes, int n_in, void* d_out, int out_size, void* d_ws, size_t ws_size, hipStream_t stream) {
    static int grid = 0;
    if (grid == 0) {
        if (n_in != 19 || (size_t)out_size != O_END || ws_size < WS_END) { fprintf(stderr, "kernel_launch: unexpected shapes (n_in %d, out %d, ws %zu); nothing launched\n", n_in, out_size, ws_size); grid = -1; return; }
        int dev = 0, cus = 0;
        if (hipGetDevice(&dev) != hipSuccess || hipDeviceGetAttribute(&cus, hipDeviceAttributeMultiprocessorCount, dev) != hipSuccess) { grid = -1; return; }
        if (hipFuncSetAttribute((const void*)hyb_fwd, hipFuncAttributeMaxDynamicSharedMemorySize, LDS_BYTES) != hipSuccess) { fprintf(stderr, "kernel_launch: hipFuncSetAttribute failed\n"); grid = -1; return; }
        (void)hipGetLastError();
        grid = cus;
        if (grid != 256) fprintf(stderr, "kernel_launch: %d CUs; this build's phase maps assume 256\n", grid);
    }
    if (grid < 0) return;
    if (hipMemsetAsync((char*)d_ws + WS_CTL, 0, CTL_ZERO_BYTES, stream) != hipSuccess) return;
    Args a{};
    for (int i = 0; i < 19; ++i) a.in[i] = (const float*)d_in[i];
    a.out = (float*)d_out; a.ws = (unsigned char*)d_ws;
    if (PROBE_REPEAT < 0) { a.ph_lo = 0; a.ph_hi = N_PHASES; hipLaunchKernelGGL(hyb_fwd, dim3(grid), dim3(512), LDS_BYTES, stream, a); }
    else {
        a.ph_lo = 0; a.ph_hi = PROBE_REPEAT + 1; a.li = 0; a.qsel = 0; hipLaunchKernelGGL(hyb_fwd, dim3(grid), dim3(512), LDS_BYTES, stream, a);
        a.ph_lo = PROBE_REPEAT; a.ph_hi = PROBE_REPEAT + 1; a.li = 1; a.qsel = PROBE_QSEL; hipLaunchKernelGGL(hyb_fwd, dim3(grid), dim3(512), LDS_BYTES, stream, a);
        if (PROBE_REPEAT + 1 < N_PHASES) { a.ph_lo = PROBE_REPEAT + 1; a.ph_hi = N_PHASES; a.li = 2; a.qsel = 0; hipLaunchKernelGGL(hyb_fwd, dim3(grid), dim3(512), LDS_BYTES, stream, a); }
    }
}
```

```cpp
#include <hip/hip_runtime.h>
#include <cstdio>
#include <cstdint>
namespace pg8 {
#define PG8_LAS __attribute__((address_space(3)))
typedef unsigned short bf16_t;
typedef short bf16x8 __attribute__((ext_vector_type(8)));
typedef float f32x4 __attribute__((ext_vector_type(4)));
typedef unsigned u32x4 __attribute__((ext_vector_type(4)));
constexpr int BM = 256, BK = 64, HALF = 128, HTB = HALF * BK * 2  , STAGE_BYTES = 8 * HTB, NXCD = 8, WGM = 8;

__host__ __device__ __forceinline__ int lds_byte(int r, int c) { const int st = (r >> 4) * 2 + (c >> 5), rr = r & 15, cc = c & 31, ob = rr * 64 + cc * 2; return st * 1024 + (ob ^ (((ob >> 9) & 1) << 5)); }
__host__ __device__ __forceinline__ void stage_rc(int b, int& R, int& C) { const int st = b / 1024, sb = b % 1024, swz = sb ^ (((sb >> 9) & 1) << 5); R = (st >> 1) * 16 + swz / 64; C = (st & 1) * 32 + (swz % 64) / 2; }
__host__ __device__ __forceinline__ int perm32(int rho) { const int n = rho >> 4, i = rho & 15; return 8 * (i >> 2) + 4 * n + (i & 3); }

struct Unit { int pm, pn; };
struct Gemm { const bf16_t* A; const bf16_t* Bt; int M, N, K, ld; };

struct StaticOrder {
    int nM, nN, nwg, G, c;
    __host__ __device__ void init(int M, int N, int G_, int c_) { nM = M / BM; nN = N / BM; nwg = nM * nN; G = G_; c = c_; }
    __host__ __device__ bool next(int i, Unit& u) const {
        const long L = (long)i * G + c; if (L >= nwg) return false;
        int wgid = (int)L; { const int q = nwg / NXCD, r = nwg % NXCD, xcd = wgid % NXCD, off = wgid / NXCD; wgid = (xcd < r ? xcd * (q + 1) : r * (q + 1) + (xcd - r) * q) + off; }
        const int nig = WGM * nN, gid = wgid / nig, fm = gid * WGM, gsz = (nM - fm) < WGM ? (nM - fm) : WGM;
        u.pm = fm + ((wgid % nig) % gsz); u.pn = (wgid % nig) / gsz; return true;
    }
    __device__ __forceinline__ void a_ready(const Unit&) const {}
    __device__ __forceinline__ void done(const Unit&) const {}
};

__device__ __forceinline__ unsigned cvt_pk_bf16(float lo, float hi) { unsigned r; asm volatile("v_cvt_pk_bf16_f32 %0, %1, %2" : "=v"(r) : "v"(lo), "v"(hi)); return r; }
typedef float f32x2 __attribute__((ext_vector_type(2)));
__device__ __forceinline__ float epi_act(float x, int act) {
    const float sg = __builtin_amdgcn_rcpf(1.f + __expf(-x)); return act == 0 ? x : (act == 1 ? sg : x * sg);
}
struct EpiBf16Plain {
    static constexpr bool PERM = true, AFTER_DRAIN = false;
    bf16_t* O; int ldc; int amap; const float* gh;
    __device__ __forceinline__ void operator()(const f32x4 (&accin)[2][2][4][2], const Unit& u, int wr, int wc, int fr, int fq) const {
        const int row0 = u.pm * BM + wr * 64 + fr, col0 = u.pn * BM + wc * 32 + 8 * fq;
        int act = 0;
        if (amap) { const int pn = u.pn; act = (pn >= 12 && pn < 16) ? 1 : (((pn >= 16 && pn < 20) || pn == 26 || pn == 27 || pn >= 30) ? 2 : 0); }
        if (act) {
#pragma unroll
            for (int ai = 0; ai < 2; ++ai)
#pragma unroll
                for (int m = 0; m < 4; ++m) { bf16_t* rowp = O + (size_t)(row0 + ai * HALF + m * 16) * ldc + col0;
#pragma unroll
                    for (int bj = 0; bj < 2; ++bj) { const f32x4 v0 = accin[ai][bj][m][0], v1 = accin[ai][bj][m][1];
                        f32x4 g0 = (f32x4){1.f, 1.f, 1.f, 1.f}, g1 = g0;
                        if (u.pn >= 16 && u.pn < 20) { g0 = *(const f32x4*)(gh + (col0 - 4096) + bj * HALF); g1 = *(const f32x4*)(gh + (col0 - 4096) + bj * HALF + 4); }
                        u32x4 w; w.x = cvt_pk_bf16(epi_act(v0[0], act) * g0[0], epi_act(v0[1], act) * g0[1]); w.y = cvt_pk_bf16(epi_act(v0[2], act) * g0[2], epi_act(v0[3], act) * g0[3]);
                        w.z = cvt_pk_bf16(epi_act(v1[0], act) * g1[0], epi_act(v1[1], act) * g1[1]); w.w = cvt_pk_bf16(epi_act(v1[2], act) * g1[2], epi_act(v1[3], act) * g1[3]);
                        *(u32x4*)(rowp + bj * HALF) = w; } }
            return;
        }
        const f32x4 (&acc)[2][2][4][2] = accin;
#pragma unroll
        for (int ai = 0; ai < 2; ++ai)
#pragma unroll
            for (int m = 0; m < 4; ++m) { bf16_t* rowp = O + (size_t)(row0 + ai * HALF + m * 16) * ldc + col0;
#pragma unroll
                for (int bj = 0; bj < 2; ++bj) { const f32x4 v0 = acc[ai][bj][m][0], v1 = acc[ai][bj][m][1];
                    u32x4 w; w.x = cvt_pk_bf16(v0[0], v0[1]); w.y = cvt_pk_bf16(v0[2], v0[3]); w.z = cvt_pk_bf16(v1[0], v1[1]); w.w = cvt_pk_bf16(v1[2], v1[3]);
                    *(u32x4*)(rowp + bj * HALF) = w; } }
    }
};
typedef unsigned u32x2e __attribute__((ext_vector_type(2)));
struct EpiKV {
    static constexpr bool PERM = false, AFTER_DRAIN = false;
    float* mk; float* mv; bf16_t* kb;
    __device__ __forceinline__ void operator()(const f32x4 (&acc)[2][2][4][2], const Unit& u, int wr, int wc, int fr, int fq) const {
        const int row0 = u.pm * BM + wr * 64 + fr, col0 = u.pn * BM + wc * 32 + 4 * fq;
        const bool isk = (u.pn < 2);
#pragma unroll
        for (int ai = 0; ai < 2; ++ai)
#pragma unroll
            for (int m = 0; m < 4; ++m) { const size_t r = (size_t)(row0 + ai * HALF + m * 16);
#pragma unroll
                for (int bj = 0; bj < 2; ++bj)
#pragma unroll
                    for (int n = 0; n < 2; ++n) { const int c = col0 + bj * HALF + n * 16; const f32x4 v = acc[ai][bj][m][n];
                        if (isk) { *(f32x4*)(mk + r * 512 + c) = v; u32x2e w; w.x = cvt_pk_bf16(v[0], v[1]); w.y = cvt_pk_bf16(v[2], v[3]); *(u32x2e*)(kb + r * 512 + c) = w; }
                        else     { *(f32x4*)(mv + r * 512 + (c - 512)) = v; } } }
    }
};
struct EpiOut {
    static constexpr bool PERM = false, AFTER_DRAIN = false;
    const float* xa; const float* xb; int split; float* out;
    __device__ __forceinline__ void operator()(const f32x4 (&acc)[2][2][4][2], const Unit& u, int wr, int wc, int fr, int fq) const {
        const int row0 = u.pm * BM + wr * 64 + fr, col0 = u.pn * BM + wc * 32 + 4 * fq;
        const float* xbase = (u.pm * BM < split) ? xa : (xb - (size_t)split * 1024);
#pragma unroll
        for (int ai = 0; ai < 2; ++ai)
#pragma unroll
            for (int m = 0; m < 4; ++m) { const size_t off = (size_t)(row0 + ai * HALF + m * 16) * 1024 + col0;
#pragma unroll
                for (int bj = 0; bj < 2; ++bj)
#pragma unroll
                    for (int n = 0; n < 2; ++n) { const f32x4 xv = *(const f32x4*)(xbase + off + bj * HALF + n * 16); *(f32x4*)(out + off + bj * HALF + n * 16) = xv + acc[ai][bj][m][n]; }
                if (m & 1) asm volatile("" ::: "memory"); }
    }
};

struct EpiSlab {
    static constexpr bool PERM = false, AFTER_DRAIN = false;
    float* C;
    __device__ __forceinline__ void operator()(const f32x4 (&acc)[2][2][4][2], const Unit& u, int wr, int wc, int fr, int fq) const {
        const int row0 = u.pm * BM + wr * 64 + fr, col0 = u.pn * BM + wc * 32 + 4 * fq;
#pragma unroll
        for (int ai = 0; ai < 2; ++ai)
#pragma unroll
            for (int m = 0; m < 4; ++m) { float* rowp = C + (size_t)(row0 + ai * HALF + m * 16) * 1024 + col0;
#pragma unroll
                for (int bj = 0; bj < 2; ++bj)
#pragma unroll
                    for (int n = 0; n < 2; ++n) *(f32x4*)(rowp + bj * HALF + n * 16) = acc[ai][bj][m][n]; }
    }
};

template <class Epi, class Sched, bool ALIGN_EPI = false, bool SP2 = false>
__device__ __forceinline__ void gemm_phase(PG8_LAS unsigned char* lds, const Gemm g, const Sched& S, const Epi& E) {
    const int tid = threadIdx.x, wid = __builtin_amdgcn_readfirstlane(tid >> 6), lane = tid & 63, wr = wid >> 2, wc = wid & 3, fr = lane & 15, fq = lane >> 4;
    const int K = g.K, nt = K / BK;
    unsigned voffA[2], voffB[2];
#pragma unroll
    for (int i = 0; i < 2; ++i) { int R, C; stage_rc(tid * 16 + i * 8192, R, C); const int Rb = Epi::PERM ? ((R & ~31) + perm32(R & 31)) : R;
        voffA[i] = (unsigned)(R * g.ld + C) * 2u; voffB[i] = (unsigned)(Rb * g.ld + C) * 2u; }
    const size_t kstep = (size_t)(BK * 2);
    const size_t hstep = (size_t)HALF * g.ld * 2;
    const size_t tstep = 2 * hstep;
    const unsigned ldsw = (unsigned)wid * 1024u;
    const int aoff = lds_byte(wr * 64 + fr, fq * 8), boff = lds_byte(wc * 32 + fr, fq * 8);
#define PG8_SA(b, h) (((b) * 2 + (h)) * HTB)
#define PG8_SB(b, h) ((4 + (b) * 2 + (h)) * HTB)
#define PG8_STAGE(bufoff, gbase, voff) do { _Pragma("unroll") for (int _i = 0; _i < 2; ++_i) \
        __builtin_amdgcn_global_load_lds((const unsigned*)((const char*)(gbase) + (voff)[_i]), (PG8_LAS unsigned*)(lds + (bufoff) + ldsw + _i * 8192), 16, 0, 0); } while (0)
#define PG8_LDA(dst, b, h) do { _Pragma("unroll") for (int m = 0; m < 4; ++m) _Pragma("unroll") for (int k = 0; k < 2; ++k) dst[m][k] = *(const PG8_LAS bf16x8*)(lds + PG8_SA(b, h) + aoff + m * 2048 + k * 1024); } while (0)
#define PG8_LDB(dst, b, h) do { _Pragma("unroll") for (int n = 0; n < 2; ++n) _Pragma("unroll") for (int k = 0; k < 2; ++k) dst[n][k] = *(const PG8_LAS bf16x8*)(lds + PG8_SB(b, h) + boff + n * 2048 + k * 1024); } while (0)
#define PG8_MMA(ai, bj, At, Bt) do { __builtin_amdgcn_s_setprio(1); _Pragma("unroll") for (int m = 0; m < 4; ++m) _Pragma("unroll") for (int n = 0; n < 2; ++n) _Pragma("unroll") for (int k = 0; k < 2; ++k) \
        acc[ai][bj][m][n] = __builtin_amdgcn_mfma_f32_16x16x32_bf16(Bt[n][k], At[m][k], acc[ai][bj][m][n], 0, 0, 0); __builtin_amdgcn_s_setprio(0); } while (0)
#define PG8_WAIT_V(n) asm volatile("s_waitcnt vmcnt(" #n ")" ::: "memory")
#define PG8_WAIT_L(n) asm volatile("s_waitcnt lgkmcnt(" #n ")" ::: "memory")
#define PG8_BAR __builtin_amdgcn_s_barrier()
#define PG8_SCHED __builtin_amdgcn_sched_barrier(0)
    Unit cur, nxt; int ui = 0;
    if (!S.next(0, cur)) return;
    f32x4 acc[2][2][4][2];
#pragma unroll
    for (int a = 0; a < 2; ++a)
#pragma unroll
        for (int b = 0; b < 2; ++b)
#pragma unroll
            for (int m = 0; m < 4; ++m)
#pragma unroll
                for (int n = 0; n < 2; ++n) acc[a][b][m][n] = (f32x4){0.f, 0.f, 0.f, 0.f};
    bf16x8 At[4][2], B0[2][2], B1[2][2];
    const char* cA = (const char*)g.A + (size_t)cur.pm * tstep; const char* cB = (const char*)g.Bt + (size_t)cur.pn * tstep;
    S.a_ready(cur);
    if constexpr (SP2) {
        PG8_STAGE(PG8_SB(0, 0), cB, voffB); PG8_STAGE(PG8_SB(0, 1), cB + hstep, voffB); PG8_STAGE(PG8_SA(0, 0), cA, voffA); PG8_STAGE(PG8_SA(0, 1), cA + hstep, voffA);
        if (wr == 1) PG8_BAR;
        PG8_WAIT_V(2); PG8_BAR;
        PG8_STAGE(PG8_SB(1, 0), cB + kstep, voffB); PG8_STAGE(PG8_SA(1, 0), cA + kstep, voffA); PG8_STAGE(PG8_SB(1, 1), cB + hstep + kstep, voffB);
        PG8_WAIT_V(6); PG8_BAR;
    } else {
        PG8_STAGE(PG8_SB(0, 0), cB, voffB); PG8_STAGE(PG8_SA(0, 0), cA, voffA); PG8_STAGE(PG8_SB(0, 1), cB + hstep, voffB); PG8_STAGE(PG8_SA(0, 1), cA + hstep, voffA);
        if (wr == 1) PG8_BAR;
        PG8_WAIT_V(4); PG8_BAR;
        PG8_STAGE(PG8_SB(1, 0), cB + kstep, voffB); PG8_STAGE(PG8_SA(1, 0), cA + kstep, voffA); PG8_STAGE(PG8_SB(1, 1), cB + hstep + kstep, voffB);
        PG8_WAIT_V(6); PG8_BAR;
    }
    for (;;) {
        const bool has_next = S.next(ui + 1, nxt);
        const char* nA = has_next ? (const char*)g.A + (size_t)nxt.pm * tstep : cA; const char* nB = has_next ? (const char*)g.Bt + (size_t)nxt.pn * tstep : cB;
        for (int t = 0; t < nt; t += 2) {
            const bool last = (t == nt - 2);
            const char* a1 = cA + (size_t)(t + 1) * kstep;
            const char* a2 = last ? nA : cA + (size_t)(t + 2) * kstep; const char* b2 = last ? nB : cB + (size_t)(t + 2) * kstep;
            const char* a3 = a2 + kstep; const char* b3 = b2 + kstep;
            if (last && has_next) S.a_ready(nxt);
            if constexpr (SP2) {
            PG8_LDB(B0, 0, 0); PG8_LDB(B1, 0, 1); PG8_SCHED; PG8_LDA(At, 0, 0); PG8_STAGE(PG8_SA(1, 1), a1 + hstep, voffA);
            PG8_WAIT_V(8); PG8_WAIT_L(0); PG8_BAR; PG8_MMA(0, 0, At, B0); PG8_MMA(0, 1, At, B1); PG8_BAR; PG8_SCHED;
            PG8_LDA(At, 0, 1); PG8_STAGE(PG8_SB(0, 0), b2, voffB); PG8_STAGE(PG8_SB(0, 1), b2 + hstep, voffB); PG8_STAGE(PG8_SA(0, 0), a2, voffA);
            PG8_WAIT_V(8); PG8_WAIT_L(0); PG8_BAR; PG8_MMA(1, 0, At, B0); PG8_MMA(1, 1, At, B1); PG8_BAR; PG8_SCHED;
            PG8_LDB(B0, 1, 0); PG8_LDB(B1, 1, 1); PG8_SCHED; PG8_LDA(At, 1, 0); PG8_STAGE(PG8_SA(0, 1), a2 + hstep, voffA);
            PG8_WAIT_V(8); PG8_WAIT_L(0); PG8_BAR; PG8_MMA(0, 0, At, B0); PG8_MMA(0, 1, At, B1); PG8_BAR; PG8_SCHED;
            PG8_LDA(At, 1, 1); PG8_STAGE(PG8_SB(1, 0), b3, voffB); PG8_STAGE(PG8_SB(1, 1), b3 + hstep, voffB); PG8_STAGE(PG8_SA(1, 0), a3, voffA);
            PG8_WAIT_V(8); PG8_WAIT_L(0); PG8_BAR; PG8_MMA(1, 0, At, B0); PG8_MMA(1, 1, At, B1); PG8_BAR; PG8_SCHED;
            } else {
            PG8_LDB(B0, 0, 0); PG8_SCHED; PG8_LDA(At, 0, 0); PG8_STAGE(PG8_SA(1, 1), a1 + hstep, voffA);
            PG8_WAIT_L(8); PG8_BAR; PG8_WAIT_L(0); PG8_MMA(0, 0, At, B0); PG8_BAR; PG8_SCHED;
            PG8_LDB(B1, 0, 1); PG8_STAGE(PG8_SB(0, 0), b2, voffB);
            PG8_BAR; PG8_WAIT_L(0); PG8_MMA(0, 1, At, B1); PG8_BAR;
            PG8_LDA(At, 0, 1); PG8_STAGE(PG8_SA(0, 0), a2, voffA);
            PG8_BAR; PG8_WAIT_L(0); PG8_MMA(1, 0, At, B0); PG8_BAR; PG8_SCHED;
            PG8_STAGE(PG8_SB(0, 1), b2 + hstep, voffB);
            PG8_WAIT_V(6); PG8_BAR; PG8_MMA(1, 1, At, B1); PG8_BAR;
            PG8_LDB(B0, 1, 0); PG8_SCHED; PG8_LDA(At, 1, 0); PG8_STAGE(PG8_SA(0, 1), a2 + hstep, voffA);
            PG8_WAIT_L(8); PG8_BAR; PG8_WAIT_L(0); PG8_MMA(0, 0, At, B0); PG8_BAR; PG8_SCHED;
            PG8_LDB(B1, 1, 1); PG8_STAGE(PG8_SB(1, 0), b3, voffB);
            PG8_BAR; PG8_WAIT_L(0); PG8_MMA(0, 1, At, B1); PG8_BAR;
            PG8_LDA(At, 1, 1); PG8_STAGE(PG8_SA(1, 0), a3, voffA);
            PG8_BAR; PG8_WAIT_L(0); PG8_MMA(1, 0, At, B0); PG8_BAR; PG8_SCHED;
            PG8_STAGE(PG8_SB(1, 1), b3 + hstep, voffB);
            PG8_WAIT_V(6); PG8_BAR; PG8_MMA(1, 1, At, B1); PG8_BAR;
            }
        }
        if constexpr (ALIGN_EPI) { if (wr == 0) PG8_BAR; }
        if constexpr (!Epi::AFTER_DRAIN) { E(acc, cur, wr, wc, fr, fq); S.done(cur); }
        if (!has_next) break;
#pragma unroll
        for (int a = 0; a < 2; ++a)
#pragma unroll
            for (int b = 0; b < 2; ++b)
#pragma unroll
                for (int m = 0; m < 4; ++m)
#pragma unroll
                    for (int n = 0; n < 2; ++n) acc[a][b][m][n] = (f32x4){0.f, 0.f, 0.f, 0.f};
        cur = nxt; cA = nA; cB = nB; ++ui;
        if constexpr (ALIGN_EPI) { if (wr == 1) PG8_BAR; }
    }
    PG8_WAIT_V(0);
    if constexpr (!ALIGN_EPI) { if (wr == 0) PG8_BAR; }
    PG8_BAR;
    if constexpr (Epi::AFTER_DRAIN) { E.fused(acc, cur, wr, wc, fr, fq, lds, wid, lane); S.done(cur); }
#undef PG8_SA
#undef PG8_SB
#undef PG8_STAGE
#undef PG8_LDA
#undef PG8_LDB
#undef PG8_MMA
#undef PG8_WAIT_V
#undef PG8_WAIT_L
#undef PG8_BAR
#undef PG8_SCHED
}
}
#define GAS __attribute__((address_space(1)))
#define LAS __attribute__((address_space(3)))
typedef unsigned short bf16;
typedef unsigned v4u __attribute__((ext_vector_type(4)));
typedef float f32x4 __attribute__((ext_vector_type(4)));
typedef short bf16x8 __attribute__((ext_vector_type(8)));
typedef GAS unsigned gu32;
typedef GAS unsigned long long gu64;
#define RLX_AGENT __ATOMIC_RELAXED, __HIP_MEMORY_SCOPE_AGENT
#define LDS_WAIT() asm volatile("s_waitcnt lgkmcnt(0)" ::: "memory")
#define VM_WAIT() asm volatile("s_waitcnt vmcnt(0)" ::: "memory")
__device__ __forceinline__ unsigned long long rt() { return __builtin_amdgcn_s_memrealtime(); }
__device__ __forceinline__ unsigned f2bf(float f) { unsigned u = __builtin_bit_cast(unsigned, f); return (u + 0x7fffu + ((u >> 16) & 1u)) >> 16; }
__device__ __forceinline__ unsigned pk2(float lo, float hi) { return f2bf(lo) | (f2bf(hi) << 16); }

#define XB_TMO      128
#define XB_XCNT(j)  (256  + 64 * (j))
#define XB_XSUB(j)  (1280 + 64 * (j))
#define XB_XGEN(j)  (2304 + 64 * (j))
#define XB_TOP      3328
#define XB_TOPGEN   3392
#define XCD_BAR_WORDS 3456
#define XB_SPIN_CAP (1u << 18)

__device__ __forceinline__ unsigned xb_ld(unsigned* p)              { return __hip_atomic_load(p, __ATOMIC_RELAXED, __HIP_MEMORY_SCOPE_AGENT); }
__device__ __forceinline__ unsigned xb_add(unsigned* p, unsigned v) { return __hip_atomic_fetch_add(p, v, __ATOMIC_RELAXED, __HIP_MEMORY_SCOPE_AGENT); }
__device__ __forceinline__ unsigned xb_xcc_id() { return (unsigned)__builtin_amdgcn_s_getreg((3 << 11) | 20) & 0xFu; }
#define XB_SPIN(cond, bar) do { unsigned _sp = 0; while (cond) { __builtin_amdgcn_s_sleep(1); \
    if ((++_sp & 255u) == 0u) { if (xb_ld(&(bar)[XB_TMO])) break; if (_sp > XB_SPIN_CAP) { atomicAdd(&(bar)[XB_TMO], 1u); break; } } } } while (0)

struct XcdBarrier {
    unsigned* bar; unsigned x;
    volatile LAS unsigned* st;
};

__device__ __forceinline__ XcdBarrier xcd_barrier_post(unsigned* bar, volatile LAS unsigned* st) {
    XcdBarrier b; b.bar = bar; b.x = xb_xcc_id(); b.st = st;
    if (threadIdx.x == 0) (void)xb_add(&bar[XB_XCNT(b.x)], 1u);
    return b;
}
__device__ __forceinline__ void xcd_barrier_complete(unsigned* bar, unsigned x, unsigned& nloc, unsigned& nx) {
    const unsigned G = gridDim.x * gridDim.y * gridDim.z;
    unsigned sum, cnt, mine, sp = 0u;
    for (;;) {
        sum = 0u; cnt = 0u; mine = 0u;
#pragma unroll
        for (unsigned j = 0; j < 16; ++j) { const unsigned c = xb_ld(&bar[XB_XCNT(j)]); sum += c; cnt += (c > 0u) ? 1u : 0u; mine = (j == x) ? c : mine; }
        if (sum == G) break;
        __builtin_amdgcn_s_sleep(1);
        if ((++sp & 255u) == 0u) { if (xb_ld(&bar[XB_TMO])) break; if (sp > XB_SPIN_CAP) { atomicAdd(&bar[XB_TMO], 1u); break; } }
    }
    nloc = mine > 0u ? mine : 1u; nx = cnt > 0u ? cnt : 1u;
}

__device__ __forceinline__ void xcd_barrier(const XcdBarrier& b) {
    asm volatile("s_waitcnt vmcnt(0)" ::: "memory");
    __syncthreads();
    if (threadIdx.x == 0) {
        unsigned* bar = b.bar;
        __builtin_amdgcn_s_waitcnt(0);
        unsigned nloc = b.st[0], nx = b.st[1];
        if (nloc == 0u) { xcd_barrier_complete(bar, b.x, nloc, nx); b.st[0] = nloc; b.st[1] = nx; }
        const unsigned old = xb_add(&bar[XB_XSUB(b.x)], 1u);
        const unsigned gen = old / nloc;
        if (old + 1u == (gen + 1u) * nloc) {
            __builtin_amdgcn_fence(__ATOMIC_RELEASE, "agent");
            asm volatile("s_waitcnt vmcnt(0)" ::: "memory");
            const unsigned og = xb_add(&bar[XB_TOP], 1u);
            const unsigned tg = og / nx;
            if (og + 1u == (tg + 1u) * nx) xb_add(&bar[XB_TOPGEN], 1u);
            else XB_SPIN(xb_ld(&bar[XB_TOPGEN]) == tg, bar);
            __builtin_amdgcn_fence(__ATOMIC_ACQUIRE, "agent");
            xb_add(&bar[XB_XGEN(b.x)], 1u);
            asm volatile("s_waitcnt vmcnt(0)" ::: "memory");
        } else {
            XB_SPIN(xb_ld(&bar[XB_XGEN(b.x)]) == gen, bar);
            __builtin_amdgcn_fence(__ATOMIC_ACQUIRE, "agent");
            asm volatile("s_waitcnt vmcnt(0)" ::: "memory");
        }
    }
    __syncthreads();
}

#define DI __device__ __forceinline__
typedef float f32x16 __attribute__((ext_vector_type(16)));
typedef unsigned u32x2 __attribute__((ext_vector_type(2)));
typedef float f32x2v __attribute__((ext_vector_type(2)));
typedef __bf16 bf16x2_t __attribute__((ext_vector_type(2)));
#define MFMA32(a, b, c) __builtin_amdgcn_mfma_f32_32x32x16_bf16((a), (b), (c), 0, 0, 0)
#define MFMA16(a, b, c) __builtin_amdgcn_mfma_f32_16x16x32_bf16((a), (b), (c), 0, 0, 0)

DI unsigned cvtpk(float lo, float hi) { f32x2v v = {lo, hi}; bf16x2_t b = __builtin_convertvector(v, bf16x2_t); return __builtin_bit_cast(unsigned, b); }
DI float bf_lo(unsigned w) { return __uint_as_float(w << 16); }
DI float bf_hi(unsigned w) { return __uint_as_float(w & 0xffff0000u); }
DI float sigmoid_f(float x) { return __builtin_amdgcn_rcpf(1.f + __expf(-x)); }
DI float silu_f(float x) { return x * __builtin_amdgcn_rcpf(1.f + __expf(-x)); }
DI float wave_sum(float v) {
#pragma unroll
    for (int o = 1; o < 64; o <<= 1) v += __shfl_xor(v, o);
    return v;
}
DI float wave_max(float v) {
#pragma unroll
    for (int o = 1; o < 64; o <<= 1) v = fmaxf(v, __shfl_xor(v, o));
    return v;
}
template <int CTRL> DI float dpp_f(float v) { return __builtin_bit_cast(float, __builtin_amdgcn_update_dpp(0, __builtin_bit_cast(int, v), CTRL, 0xF, 0xF, false)); }
DI float sum8(float v) { v += dpp_f<0xB1>(v); v += dpp_f<0x4E>(v); v += dpp_f<0x141>(v); return v; }
DI float sum16(float v) { v = sum8(v); v += dpp_f<0x140>(v); return v; }
DI int crow(int r, int hi) { return (r & 3) + 8 * (r >> 2) + 4 * hi; }
DI bf16x8 pack8(const f32x16& x, int s) {
    v4u p; p.x = cvtpk(x[8 * s + 0], x[8 * s + 1]); p.y = cvtpk(x[8 * s + 2], x[8 * s + 3]); p.z = cvtpk(x[8 * s + 4], x[8 * s + 5]); p.w = cvtpk(x[8 * s + 6], x[8 * s + 7]);
    return __builtin_bit_cast(bf16x8, p);
}

constexpr int DM = 1024, NB = 8, SEQ = 2048, MP = NB * SEQ, DB = 128, DS = 8, MS = DB * DS, MT = MP + MS;
constexpr int NPROJ = 8192, INCOLS = 8200, NMEMTOK = 256, MMEM = NB * NMEMTOK;
constexpr int PC_Q = 0, PC_K = 1024, PC_V = 2048, PC_O = 3072, PC_Z = 4096, PC_BG = 5120, PC_CG = 5632, PC_XC = 6144, PC_ZCV = 6656, PC_QX = 7168, PC_ZX = 7680;
constexpr int YC_ML = 0, YC_CV = 1024, YC_XA = 1536, NMIX = 2048;
constexpr float EPS = 1e-6f;
constexpr size_t O_YP = 0, O_YS = (size_t)MP * DM, O_CP = O_YS + (size_t)MS * DM, O_NP = O_CP + (size_t)NB * 4 * 65536, O_MP = O_NP + NB * 4 * 256, O_CVP = O_MP + NB * 4,
                 O_MK = O_CVP + NB * 2 * 512, O_MV = O_MK + (size_t)MMEM * 512, O_CS = O_MV + (size_t)MMEM * 512, O_NS = O_CS + (size_t)DB * 4 * 65536, O_MS = O_NS + DB * 4 * 256,
                 O_CVS = O_MS + DB * 4, O_END = O_CVS + DB * 2 * 512;
static_assert(O_END == 55853600, "d_out map");
constexpr size_t MiB = 1u << 20;
constexpr size_t WS_CTL = 0, CTL_ZERO_BYTES = 1 * MiB;
constexpr size_t WS_WIN = 2 * MiB, WS_WOUT = 18 * MiB, WS_WKV = 22 * MiB, WS_MEMN = 24 * MiB, WS_KMEM = 28 * MiB, WS_VT = 30 * MiB, WS_GATES = 32 * MiB, WS_XN = 34 * MiB, WS_YMIX = 68 * MiB,
                 WS_PROJ = 136 * MiB, WS_SSQ = 408 * MiB, WS_SLAB = 412 * MiB, WS_END = 428 * MiB;
static_assert(WS_XN + (size_t)MT * DM * 2 <= WS_YMIX && WS_YMIX + (size_t)MT * NMIX * 2 <= WS_PROJ && WS_PROJ + (size_t)MT * NPROJ * 2 <= WS_SSQ && WS_SSQ + (size_t)MP * 4 * 16 * 4 <= WS_END, "d_ws map");
constexpr int CW_BAR = 4096, CW_QHEAD = 32768;
constexpr int LDS_BYTES = 155648, MISC_OFF = LDS_BYTES - 256;

DI void p0_transpose_item(const float* W, int ldw, int srccol, int k0, bf16* WT, int K, int dstrow, float scale, LAS float* scr, int lane) {
#pragma unroll 8
    for (int i = 0; i < 32; ++i) { const int kk = 2 * i + (lane >> 5); scr[kk * 33 + (lane & 31)] = W[(size_t)(k0 + kk) * ldw + srccol + (lane & 31)]; }
    LDS_WAIT(); asm volatile("" ::: "memory");
    const int c = lane & 7;
#pragma unroll
    for (int j = 0; j < 4; ++j) { const int n = (lane >> 3) + 8 * j; const LAS float* s = scr + (8 * c) * 33 + n;
        v4u o; o.x = pk2(s[0 * 33] * scale, s[1 * 33] * scale); o.y = pk2(s[2 * 33] * scale, s[3 * 33] * scale); o.z = pk2(s[4 * 33] * scale, s[5 * 33] * scale); o.w = pk2(s[6 * 33] * scale, s[7 * 33] * scale);
        *(GAS v4u*)(WT + (size_t)(dstrow + n) * K + k0 + 8 * c) = o; }
    LDS_WAIT(); asm volatile("" ::: "memory");
}
DI void xn_row(const float* xrow, const float* g, bf16* orow, float* gates_row, const LAS float* gw, const float* b_if, int lane) {
    const f32x4* xr = (const f32x4*)xrow + lane;
    f32x4 v[4]; float s = 0.f;
#pragma unroll
    for (int j = 0; j < 4; ++j) { v[j] = xr[64 * j]; s += (v[j].x * v[j].x + v[j].y * v[j].y) + (v[j].z * v[j].z + v[j].w * v[j].w); }
    const float r = rsqrtf(wave_sum(s) * (1.f / 1024.f) + EPS);
    if (gates_row) {
        float dot[8];
#pragma unroll
        for (int q = 0; q < 8; ++q) { float a = 0.f;
#pragma unroll
            for (int j = 0; j < 4; ++j) { const f32x4 w = *(const LAS f32x4*)(gw + q * 1024 + 256 * j + 4 * lane); a += (v[j].x * w.x + v[j].y * w.y) + (v[j].z * w.z + v[j].w * w.w); }
            dot[q] = wave_sum(a); }
        float mine = dot[0];
#pragma unroll
        for (int q = 1; q < 8; ++q) mine = (lane == q) ? dot[q] : mine;
        if (lane < 8) { float pre = mine * r + b_if[lane];
            if (lane >= 4) pre = (pre >= 0.f) ? -log1pf(expf(-pre)) : (pre - log1pf(expf(pre)));
            gates_row[lane] = pre; }
    }
    const f32x4* g4 = (const f32x4*)g + lane;
    u32x2* o8 = (u32x2*)orow + lane;
#pragma unroll
    for (int j = 0; j < 4; ++j) { const f32x4 gv = g4[64 * j]; u32x2 o; o.x = cvtpk(v[j].x * r * gv.x, v[j].y * r * gv.y); o.y = cvtpk(v[j].z * r * gv.z, v[j].w * r * gv.w); o8[64 * j] = o; }
}

constexpr int NSL = 2, DVB = 32 * NSL;
constexpr int SC_Q = 0, SC_K = 32768, SC_CB = 65536, CBP = 528, SC_SM = SC_CB + DVB * CBP, SC_VT = SC_SM + 8192, VTP = 144, VTB = DVB * VTP, SC_SO = SC_VT + 2 * VTB, SC_SZ = SC_SO + 64 * DVB * 2,
              SC_MISC = SC_SZ + 64 * DVB * 2, SC_GSET = 1536;
constexpr int SM_WS = SC_MISC, SM_HDMIN = SC_MISC + 256, SM_SCAL = SC_MISC + 512,
              SM_RSP = SC_MISC + 3072, SM_QN = SC_MISC + 3584, SM_HINV = SC_MISC + 3840, SM_N = SC_MISC + 4096;
static_assert(SM_SCAL + 16 <= SC_MISC + SC_GSET && SM_N + 2048 <= MISC_OFF, "scan LDS map");
#define LF(off) (*(LAS float*)(lds + (off)))
#define OPAQUE(x) asm volatile("" : "+v"(x))
#define SCAN_BAR() do { asm volatile("s_waitcnt lgkmcnt(0)" ::: "memory"); __builtin_amdgcn_s_barrier(); asm volatile("" ::: "memory"); } while (0)
typedef short v4i16_t __attribute__((ext_vector_type(4)));
DI int skey(int row) { return ((row & 3) << 2) | ((-(row >> 2)) & 3); }
DI bf16x8 tr_frag(LAS unsigned char* p0, LAS unsigned char* p1) {
    const v4i16_t lo = __builtin_amdgcn_ds_read_tr16_b64_v4i16((LAS v4i16_t*)p0), hi = __builtin_amdgcn_ds_read_tr16_b64_v4i16((LAS v4i16_t*)p1);
    return (bf16x8){lo[0], lo[1], lo[2], lo[3], hi[0], hi[1], hi[2], hi[3]};
}
DI void glds16(const void* gsrc, unsigned lds_dst) { unsigned keep;
    asm volatile("s_mov_b32 %0, m0\n\ts_mov_b32 m0, %2\n\ts_nop 0\n\tglobal_load_lds_dwordx4 %1, off\n\ts_mov_b32 m0, %0" : "=&s"(keep) : "v"(gsrc), "s"(lds_dst) : "memory"); }
DI void dma_tile(LAS unsigned char* lds, int tile_off, const bf16* src  , int w, int lane) {
    const int rsub = lane >> 5, pc = lane & 31; const unsigned lbase = (unsigned)(unsigned long)(lds + tile_off);
#pragma unroll
    for (int i = 0; i < 4; ++i) { const int row = 2 * (4 * w + i) + rsub; const int lc = pc ^ skey(row & 15);
        glds16(src + (size_t)row * NPROJ + lc * 8, (unsigned)__builtin_amdgcn_readfirstlane((int)(lbase + (unsigned)((4 * w + i) * 1024)))); }
}
DI float rdlane(float v, int l) { return __builtin_bit_cast(float, __builtin_amdgcn_readlane(__builtin_bit_cast(int, v), l)); }
template <int CTRL, int RMASK> DI float dpp_add0(float v) { return v + __builtin_bit_cast(float, __builtin_amdgcn_update_dpp(0, __builtin_bit_cast(int, v), CTRL, RMASK, 0xF, false)); }
DI float scan_gates(LAS unsigned char* lds, int set, float gi, float gf, float m_run, int lane) {
    float F = gf;
    F = dpp_add0<0x111, 0xF>(F); F = dpp_add0<0x112, 0xF>(F); F = dpp_add0<0x114, 0xF>(F); F = dpp_add0<0x118, 0xF>(F);
    F = dpp_add0<0x142, 0xA>(F); F = dpp_add0<0x143, 0xC>(F);
    const float a = gi - F;
    float mx = a;
    mx = fmaxf(mx, dpp_f<0xB1>(mx)); mx = fmaxf(mx, dpp_f<0x4E>(mx)); mx = fmaxf(mx, dpp_f<0x141>(mx)); mx = fmaxf(mx, dpp_f<0x140>(mx));
    const float amax = fmaxf(fmaxf(rdlane(mx, 0), rdlane(mx, 16)), fmaxf(rdlane(mx, 32), rdlane(mx, 48)));
    const float G = fmaxf(m_run, amax);
    const float F63 = rdlane(F, 63);
    const int so = set * SC_GSET;
    LF(SM_WS + so + lane * 4) = __expf(a - G); LF(SM_HDMIN + so + lane * 4) = __expf(-(F + G));
    if (lane == 0) { LF(SM_SCAL + so) = __expf(m_run - G); LF(SM_SCAL + so + 4) = F63 + G; }
    return F63 + G;
}
DI void scan_stage_vt(LAS unsigned char* lds, int buf, int set, v4u vv, int tid) {
    const int s = tid >> 3, p8 = tid & 7; const float wsv = LF(SM_WS + set * SC_GSET + s * 4);
    const int vb = SC_VT + buf * VTB + (8 * p8) * VTP + s * 2;
#pragma unroll
    for (int i = 0; i < 4; ++i) { const unsigned a = cvtpk(bf_lo(vv[i]) * wsv, bf_hi(vv[i]) * wsv);
        *(LAS unsigned short*)(lds + vb + (2 * i) * VTP) = (unsigned short)(a & 0xffffu); *(LAS unsigned short*)(lds + vb + (2 * i + 1) * VTP) = (unsigned short)(a >> 16); }
}
DI void scan_job(LAS unsigned char* lds, int bh, int pr, const bf16* PROJ, const float* GATES, bf16* YMIX, float* SSQ, float* outC, float* outN, float* outM, int tid0) {
    const int w = __builtin_amdgcn_readfirstlane(tid0 >> 6);
    const int b = bh >> 2, h = bh & 3;
    const size_t row_base = (size_t)b * SEQ;
    const int colb = h * 256 + DVB * pr;
    constexpr int NCH = SEQ / 64;
    f32x16 Cacc[NSL];
#pragma unroll
    for (int q = 0; q < NSL; ++q)
#pragma unroll
        for (int r = 0; r < 16; ++r) Cacc[q][r] = 0.f;
    float m_run = 0.f;
    if (tid0 < 256) LF(SM_N + tid0 * 4) = 0.f;
    for (int e = tid0; e < DVB * CBP / 4; e += 512) *(LAS unsigned*)(lds + SC_CB + e * 4) = 0u;
    { const int lane = tid0 & 63; const bf16* p = PROJ + row_base * NPROJ + h * 256;
      dma_tile(lds, SC_Q, p + PC_Q, w, lane); dma_tile(lds, SC_K, p + PC_K, w, lane);
      if (w == 0) m_run = scan_gates(lds, 0, GATES[(row_base + lane) * 8 + h], GATES[(row_base + lane) * 8 + 4 + h], 0.f, lane);
      __syncthreads();
      scan_stage_vt(lds, 0, 0, *(const v4u*)(PROJ + (row_base + (tid0 >> 3)) * NPROJ + PC_V + colb + (tid0 & 7) * 8), tid0); }
    v4u vnext = *(const v4u*)(PROJ + (row_base + 64 + (tid0 >> 3)) * NPROJ + PC_V + colb + (tid0 & 7) * 8);
    v4u co = *(const v4u*)(PROJ + (row_base + (tid0 >> 3)) * NPROJ + PC_O + colb + (tid0 & 7) * 8), cz = *(const v4u*)(PROJ + (row_base + (tid0 >> 3)) * NPROJ + PC_Z + colb + (tid0 & 7) * 8);
    float ngi = 0.f, ngf = 0.f;
    if (w == 0) { const int lane = tid0 & 63; ngi = GATES[(row_base + 64 + lane) * 8 + h]; ngf = GATES[(row_base + 64 + lane) * 8 + 4 + h]; }
    asm volatile("s_waitcnt vmcnt(0)" ::: "memory");
    __syncthreads();
    unsigned ypk[NSL][2]; float q2[NSL][4];
#pragma unroll 1
    for (int c = 0; c <= NCH; ++c) {
        const int tid = tid0;
        const int lane = tid & 63, hh = lane >> 5, l31 = lane & 31, l15 = lane & 15, lq = lane >> 4;
        const int gq = (lane & 15) >> 2, gp = lane & 3, g1 = (lane >> 4) & 1;
        const int rt = w >> 1, ct = w & 1;
        if (c > 0) { const size_t rp = row_base + (size_t)(c - 1) * 64; const int t0 = 16 * rt + 4 * lq;
#pragma unroll
            for (int q = 0; q < NSL; ++q) { const int e = 16 * (ct + 2 * q) + l15;
                bf16* yp = YMIX + (rp + t0) * NMIX + YC_ML + colb + e;
                yp[0] = (bf16)(ypk[q][0] & 0xffffu); yp[NMIX] = (bf16)(ypk[q][0] >> 16); yp[2 * NMIX] = (bf16)(ypk[q][1] & 0xffffu); yp[3 * NMIX] = (bf16)(ypk[q][1] >> 16);
                if (l15 == 0) {
#pragma unroll
                    for (int j = 0; j < 4; ++j) SSQ[((rp + t0 + j) * 4 + h) * 16 + 4 * pr + ct + 2 * q] = q2[q][j]; } } }
        if (c == NCH) break;
        const size_t r0 = row_base + (size_t)c * 64;
        const int par = c & 1, gs = par * SC_GSET;
        const bool more = (c + 1 < NCH);
#ifdef PROBE_SPIN
        const unsigned long long tsA = __builtin_amdgcn_s_memtime();
#endif
        const float wC = LF(SM_SCAL + gs);
        bf16x8 qf[8];
        { const int kq = skey(l15); const int abase = SC_Q + (16 * rt + l15) * 512;
#pragma unroll
          for (int ks = 0; ks < 8; ++ks) qf[ks] = *(const LAS bf16x8*)(lds + abase + (((4 * ks + lq) ^ kq) << 4));
          const int ct0 = ct * 2, bbase = SC_K + (16 * ct0 + l15) * 512;
          f32x4 sacc[2]; sacc[0] = (f32x4){0.f, 0.f, 0.f, 0.f}; sacc[1] = sacc[0];
#pragma unroll
          for (int ks = 0; ks < 8; ++ks)
#pragma unroll
              for (int n = 0; n < 2; ++n) { const bf16x8 bf = *(const LAS bf16x8*)(lds + bbase + n * 16 * 512 + (((4 * ks + lq) ^ kq) << 4)); sacc[n] = MFMA16(qf[ks], bf, sacc[n]); }
          float rs[4] = {0.f, 0.f, 0.f, 0.f};
          const int t0 = 16 * rt + 4 * lq;
#pragma unroll
          for (int n = 0; n < 2; ++n) { const int s = 16 * (ct0 + n) + l15; const float wss = LF(SM_WS + gs + s * 4);
              float v[4];
#pragma unroll
              for (int j = 0; j < 4; ++j) { v[j] = (s <= t0 + j) ? sacc[n][j] : 0.f; rs[j] += v[j] * wss; }
              const unsigned p01 = cvtpk(v[0], v[1]), p23 = cvtpk(v[2], v[3]);
#pragma unroll
              for (int j = 0; j < 4; ++j) { const int t = t0 + j; const unsigned pv = (j < 2) ? p01 : p23;
                  *(LAS unsigned short*)(lds + SC_SM + t * 128 + ((((s >> 3) ^ ((t >> 1) & 7))) << 4) + (s & 7) * 2) = (unsigned short)((j & 1) ? (pv >> 16) : (pv & 0xffffu)); } }
#pragma unroll
          for (int j = 0; j < 4; ++j) { const float v = sum16(rs[j]);
              if (l15 == 0) LF(SM_RSP + (ct * 64 + t0 + j) * 4) = v; }
        }
        { const int t = tid >> 3, part = tid & 7; float acc = 0.f; const int kt = skey(t & 15);
#pragma unroll
          for (int cc = 0; cc < 4; ++cc) { const int cx = 4 * part + cc; const v4u qv = *(const LAS v4u*)(lds + SC_Q + t * 512 + ((cx ^ kt) << 4));
              const f32x4 n0 = *(const LAS f32x4*)(lds + SM_N + par * 1024 + cx * 32), n1 = *(const LAS f32x4*)(lds + SM_N + par * 1024 + cx * 32 + 16);
              acc += bf_lo(qv.x) * n0.x + bf_hi(qv.x) * n0.y + bf_lo(qv.y) * n0.z + bf_hi(qv.y) * n0.w + bf_lo(qv.z) * n1.x + bf_hi(qv.z) * n1.y + bf_lo(qv.w) * n1.z + bf_hi(qv.w) * n1.w; }
          acc = sum8(acc);
          if (part == 0) LF(SM_QN + t * 4) = acc;
        }
        { const int trx = 2 * g1 + (gp >> 1), trk1 = hh ? 2 : 0, trk2 = hh ? 1 : 3, tro = (8 * hh + gq) * 512 + 8 * (gp & 1);
          const int c1 = (((4 * w) ^ (4 * gq)) + (trx ^ trk1)) << 4, c2 = (((4 * w) ^ (4 * gq)) + (trx ^ trk2)) << 4;
          const int vb = SC_VT + par * VTB + l31 * VTP + hh * 16;
#pragma unroll
          for (int q = 0; q < NSL; ++q)
#pragma unroll
            for (int r = 0; r < 16; ++r) Cacc[q][r] *= wC;
#pragma unroll
          for (int ks = 0; ks < 4; ++ks) { const bf16x8 afr = tr_frag(lds + SC_K + ks * 8192 + tro + c1, lds + SC_K + ks * 8192 + tro + 4 * 512 + c2);
#pragma unroll
              for (int q = 0; q < NSL; ++q) { const bf16x8 bfr = *(const LAS bf16x8*)(lds + vb + q * 32 * VTP + ks * 32); Cacc[q] = MFMA32(afr, bfr, Cacc[q]); } } }
        { bf16x8 wsb[2];
#pragma unroll
          for (int ks = 0; ks < 2; ++ks) { const f32x4 w0 = *(const LAS f32x4*)(lds + SM_WS + gs + (32 * ks + 8 * lq) * 4), w1 = *(const LAS f32x4*)(lds + SM_WS + gs + (32 * ks + 8 * lq) * 4 + 16);
              v4u o; o.x = cvtpk(w0.x, w0.y); o.y = cvtpk(w0.z, w0.w); o.z = cvtpk(w1.x, w1.y); o.w = cvtpk(w1.z, w1.w);
              if (l15 != 0) o = (v4u){0u, 0u, 0u, 0u};
              wsb[ks] = __builtin_bit_cast(bf16x8, o); }
          const int nq = l15 >> 2, np = l15 & 3;
#pragma unroll
          for (int dti = 0; dti < 2; ++dti) { const int dt = 2 * w + dti; f32x4 nacc = (f32x4){0.f, 0.f, 0.f, 0.f};
#pragma unroll
              for (int ks = 0; ks < 2; ++ks) { const int ra = 32 * ks + 8 * lq + nq, rb = ra + 4; const int lc = 2 * dt + (np >> 1);
                  const bf16x8 afr = tr_frag(lds + SC_K + ra * 512 + ((lc ^ skey(ra & 15)) << 4) + 8 * (np & 1), lds + SC_K + rb * 512 + ((lc ^ skey(rb & 15)) << 4) + 8 * (np & 1));
                  nacc = MFMA16(afr, wsb[ks], nacc); }
              if (l15 == 0) {
#pragma unroll
                  for (int j = 0; j < 4; ++j) { const int d = 16 * dt + 4 * lq + j; LF(SM_N + (par ^ 1) * 1024 + d * 4) = wC * LF(SM_N + par * 1024 + d * 4) + nacc[j]; } } } }
        asm volatile("" :: "v"(vnext), "v"(co), "v"(cz), "v"(ngi), "v"(ngf));
        SCAN_BAR();
#ifdef PROBE_SPIN
        const unsigned long long tsB = __builtin_amdgcn_s_memtime();
#endif
        if (more) { const bf16* p = PROJ + (r0 + 64) * NPROJ + h * 256; dma_tile(lds, SC_Q, p + PC_Q, w, lane); dma_tile(lds, SC_K, p + PC_K, w, lane); }
        v4u vnn = (v4u){0u, 0u, 0u, 0u}, con = vnn, czn = vnn; float ngi2 = 0.f, ngf2 = 0.f;
        if (more) { con = *(const v4u*)(PROJ + (r0 + 64 + (tid >> 3)) * NPROJ + PC_O + colb + (tid & 7) * 8); czn = *(const v4u*)(PROJ + (r0 + 64 + (tid >> 3)) * NPROJ + PC_Z + colb + (tid & 7) * 8); }
        if (c + 2 < NCH) { vnn = *(const v4u*)(PROJ + (r0 + 128 + (tid >> 3)) * NPROJ + PC_V + colb + (tid & 7) * 8);
            if (w == 0) { ngi2 = GATES[(r0 + 128 + lane) * 8 + h]; ngf2 = GATES[(r0 + 128 + lane) * 8 + 4 + h]; } }
        unsigned pfx = 0u;
        if (c + 3 < NCH) {
            if (tid < 128) { const int ln = pr * 128 + tid;
                pfx = *(const unsigned*)(PROJ + (r0 + 192 + (ln >> 3)) * NPROJ + h * 256 + ((ln >> 2) & 1) * 1024 + (ln & 3) * 64); }
            else if (tid < 320) { const int e = tid - 128; const int rr = e / 3, wh = e - 3 * rr;
                pfx = *(const unsigned*)(PROJ + (r0 + (wh == 0 ? 192 : 128) + rr) * NPROJ + colb + (wh == 0 ? PC_V : (wh == 1 ? PC_O : PC_Z))); } }
        if (tid < 64) { const float rowsum = LF(SM_RSP + tid * 4) + LF(SM_RSP + 256 + tid * 4); const float den = wC * LF(SM_QN + tid * 4) + rowsum;
            LF(SM_HINV + tid * 4) = __builtin_amdgcn_rcpf(fmaxf(fabsf(den), LF(SM_HDMIN + gs + tid * 4))); }
        if (w == 0 && more) m_run = scan_gates(lds, par ^ 1, ngi, ngf, m_run, lane);
        *(LAS v4u*)(lds + SC_SO + (tid >> 3) * (DVB * 2) + (tid & 7) * 16) = co; *(LAS v4u*)(lds + SC_SZ + (tid >> 3) * (DVB * 2) + (tid & 7) * 16) = cz;
        f32x4 num[NSL];
        { const int t = 16 * rt + l15; const int sw = (t >> 1) & 7;
#pragma unroll
          for (int q = 0; q < NSL; ++q) { num[q] = (f32x4){0.f, 0.f, 0.f, 0.f};
              const int cb0 = SC_CB + (16 * (ct + 2 * q) + l15) * CBP + lq * 16;
#pragma unroll
              for (int ks = 0; ks < 8; ++ks) { const bf16x8 bf = *(const LAS bf16x8*)(lds + cb0 + ks * 64); num[q] = MFMA16(qf[ks], bf, num[q]); }
              num[q] = num[q] * wC; }
#pragma unroll
          for (int ks = 0; ks < 2; ++ks) { const bf16x8 af = *(const LAS bf16x8*)(lds + SC_SM + t * 128 + (((4 * ks + lq) ^ sw) << 4));
#pragma unroll
              for (int q = 0; q < NSL; ++q) { const bf16x8 bf = *(const LAS bf16x8*)(lds + SC_VT + par * VTB + (16 * (ct + 2 * q) + l15) * VTP + lq * 16 + ks * 64); num[q] = MFMA16(af, bf, num[q]); } } }
        SCAN_BAR();
#ifdef PROBE_SPIN
        const unsigned long long tsC = __builtin_amdgcn_s_memtime();
#endif
        if (more) scan_stage_vt(lds, par ^ 1, par ^ 1, vnext, tid);
#pragma unroll
        for (int q = 0; q < NSL; ++q)
#pragma unroll
          for (int g = 0; g < 4; ++g) { u32x2 pk; pk.x = cvtpk(Cacc[q][4 * g], Cacc[q][4 * g + 1]); pk.y = cvtpk(Cacc[q][4 * g + 2], Cacc[q][4 * g + 3]);
            *(LAS u32x2*)(lds + SC_CB + (32 * q + l31) * CBP + (32 * w + 8 * g + 4 * hh) * 2) = pk; }
        { const int t0 = 16 * rt + 4 * lq;
#pragma unroll
          for (int q = 0; q < NSL; ++q) { const int e = 16 * (ct + 2 * q) + l15;
              float yv[4];
#pragma unroll
              for (int j = 0; j < 4; ++j) { const int t = t0 + j;
                  const float so = bf_lo((unsigned)*(const LAS unsigned short*)(lds + SC_SO + t * (DVB * 2) + e * 2)), sz = bf_lo((unsigned)*(const LAS unsigned short*)(lds + SC_SZ + t * (DVB * 2) + e * 2));
                  const float ho = so * num[q][j] * LF(SM_HINV + t * 4); q2[q][j] = ho * ho; yv[j] = ho * sz; }
              ypk[q][0] = cvtpk(yv[0], yv[1]); ypk[q][1] = cvtpk(yv[2], yv[3]);
#pragma unroll
              for (int j = 0; j < 4; ++j) q2[q][j] = sum16(q2[q][j]); }
        }
#if defined(PROBE_SPIN) && PROBE_SPIN == 4
        const unsigned long long tsW = __builtin_amdgcn_s_memtime();
#endif
        asm volatile("s_waitcnt vmcnt(0)" ::: "memory"); SCAN_BAR();
        asm volatile("" :: "v"(pfx));
        vnext = vnn; co = con; cz = czn; ngi = ngi2; ngf = ngf2;
#ifdef PROBE_SPIN
        { const unsigned long long tsD = __builtin_amdgcn_s_memtime();
          const unsigned long long dur = (PROBE_SPIN == 1) ? (tsB - tsA) : (PROBE_SPIN == 2) ? (tsC - tsB) : (PROBE_SPIN == 3) ? (tsD - tsC) :
#if PROBE_SPIN == 4
              (tsD - tsW);
#else
              0ull;
#endif
          while (__builtin_amdgcn_s_memtime() - tsD < dur) __builtin_amdgcn_s_sleep(1); }
#endif
    }
    { const int lane = tid0 & 63, hh = lane >> 5, l31 = lane & 31;
#pragma unroll
      for (int q = 0; q < NSL; ++q)
#pragma unroll
        for (int r = 0; r < 16; ++r) outC[((size_t)bh * 256 + 32 * w + crow(r, hh)) * 256 + DVB * pr + 32 * q + l31] = Cacc[q][r];
      if (pr == 0) { if (tid0 < 256) outN[bh * 256 + tid0] = LF(SM_N + (NCH & 1) * 1024 + tid0 * 4); if (tid0 == 0) outM[bh] = m_run; } }
    __syncthreads();
}

constexpr int AT_K = 0, AT_KP = 272, AT_VT = 69632, AT_VP = 520, AT_SUM = AT_VT + 128 * AT_VP;
static_assert(AT_SUM + 1024 <= MISC_OFF, "attention LDS map");
DI void attn_prompt_unit(LAS unsigned char* lds, int unit, const bf16* PROJ, const bf16* KMEM, const bf16* VT, bf16* YMIX, int tid) {
    const int lane = tid & 63, w = __builtin_amdgcn_readfirstlane(tid >> 6), hh = lane >> 5, l31 = lane & 31;
    const int b = unit >> 5, h = (unit >> 3) & 3, qb = unit & 7;
#pragma unroll
    for (int i = 0; i < 8; ++i) { const int idx = tid + 512 * i; const int key = idx >> 4, cx = idx & 15;
        const v4u v = *(const v4u*)(KMEM + (size_t)(b * 256 + key) * 512 + h * 128 + cx * 8); *(LAS v4u*)(lds + AT_K + key * AT_KP + cx * 16) = v; }
#pragma unroll
    for (int i = 0; i < 8; ++i) { const int idx = tid + 512 * i; const int d = idx >> 5, cx = idx & 31;
        const v4u v = *(const v4u*)(VT + (size_t)(h * 128 + d) * 2048 + b * 256 + cx * 8);
        u32x2 a, c; a.x = v.x; a.y = v.y; c.x = v.z; c.y = v.w;
        *(LAS u32x2*)(lds + AT_VT + d * AT_VP + cx * 16) = a; *(LAS u32x2*)(lds + AT_VT + d * AT_VP + cx * 16 + 8) = c; }
    __syncthreads();
    const size_t row0 = (size_t)b * SEQ + qb * 256 + 32 * w;
    const float c2 = 0.08838834764831845f * 1.4426950408889634f;
    float m_run = -3.0e38f, l_run = 0.f;
    f32x16 O[4];
#pragma unroll
    for (int dt = 0; dt < 4; ++dt)
#pragma unroll
        for (int r = 0; r < 16; ++r) O[dt][r] = 0.f;
    const bf16* qp = PROJ + (row0 + l31) * NPROJ + PC_QX + h * 128 + 8 * hh;
    const int kb0 = AT_K + l31 * AT_KP + hh * 16, vb0 = AT_VT + l31 * AT_VP + hh * 8;
#pragma unroll
    for (int half = 0; half < 2; ++half) {
        f32x16 acc[4];
#pragma unroll
        for (int kt = 0; kt < 4; ++kt)
#pragma unroll
            for (int r = 0; r < 16; ++r) acc[kt][r] = 0.f;
#pragma unroll
        for (int kh = 0; kh < 2; ++kh) {
            bf16x8 qf[4];
#pragma unroll
            for (int k4 = 0; k4 < 4; ++k4) qf[k4] = *(const bf16x8*)(qp + 16 * (4 * kh + k4));
#pragma unroll
            for (int k4 = 0; k4 < 4; ++k4)
#pragma unroll
                for (int kt = 0; kt < 4; ++kt) { const bf16x8 af = *(const LAS bf16x8*)(lds + kb0 + (4 * half + kt) * 32 * AT_KP + (4 * kh + k4) * 32); acc[kt] = MFMA32(af, qf[k4], acc[kt]); } }
        float mx = m_run;
#pragma unroll
        for (int kt = 0; kt < 4; ++kt)
#pragma unroll
            for (int r = 0; r < 16; ++r) mx = fmaxf(mx, acc[kt][r]);
        mx = fmaxf(mx, __shfl_xor(mx, 32));
        const float alpha = __builtin_amdgcn_exp2f((m_run - mx) * c2);
        m_run = mx;
        float sum = 0.f;
        bf16x8 pk[4][2];
#pragma unroll
        for (int kt = 0; kt < 4; ++kt) {
#pragma unroll
            for (int r = 0; r < 16; ++r) { const float p = __builtin_amdgcn_exp2f((acc[kt][r] - mx) * c2); acc[kt][r] = p; sum += p; }
            pk[kt][0] = pack8(acc[kt], 0); pk[kt][1] = pack8(acc[kt], 1); }
        sum += __shfl_xor(sum, 32);
        l_run = l_run * alpha + sum;
        if (half == 1) {
            __syncthreads();
            if (hh == 0) LF(AT_SUM + (w * 32 + l31) * 4) = alpha;
#pragma unroll
            for (int r = 0; r < 16; ++r) { const float al = LF(AT_SUM + (w * 32 + crow(r, hh)) * 4);
#pragma unroll
                for (int dt = 0; dt < 4; ++dt) O[dt][r] *= al; }
        }
#pragma unroll
        for (int kt = 0; kt < 4; ++kt)
#pragma unroll
            for (int s2 = 0; s2 < 2; ++s2)
#pragma unroll
                for (int dt = 0; dt < 4; ++dt) { const int o = vb0 + dt * 32 * AT_VP + (8 * (4 * half + kt) + 4 * s2) * 8;
                    const u32x2 lo = *(const LAS u32x2*)(lds + o), hi = *(const LAS u32x2*)(lds + o + 16);
                    v4u bv; bv.x = lo.x; bv.y = lo.y; bv.z = hi.x; bv.w = hi.y;
                    O[dt] = MFMA32(pk[kt][s2], __builtin_bit_cast(bf16x8, bv), O[dt]); }
    }
    asm volatile("s_waitcnt lgkmcnt(0)" ::: "memory");
    if (hh == 0) LF(AT_SUM + (w * 32 + l31) * 4) = l_run;
    { const int stg = AT_K + w * (32 * 264);
#pragma unroll
      for (int r = 0; r < 16; ++r) { const int q = crow(r, hh); const float inv = 1.f / LF(AT_SUM + (w * 32 + q) * 4);
#pragma unroll
        for (int dt = 0; dt < 4; ++dt) *(LAS unsigned short*)(lds + stg + q * 264 + (32 * dt + l31) * 2) = (unsigned short)f2bf(O[dt][r] * inv); }
#pragma unroll
      for (int i = 0; i < 8; ++i) { const int q = 4 * i + (lane >> 4), cx = lane & 15; const size_t row = row0 + q;
        const u32x2 oa = *(const LAS u32x2*)(lds + stg + q * 264 + cx * 16), ob = *(const LAS u32x2*)(lds + stg + q * 264 + cx * 16 + 8);
        const v4u zv = *(const v4u*)(PROJ + row * NPROJ + PC_ZX + h * 128 + cx * 8);
        v4u y; y.x = cvtpk(bf_lo(oa.x) * bf_lo(zv.x), bf_hi(oa.x) * bf_hi(zv.x)); y.y = cvtpk(bf_lo(oa.y) * bf_lo(zv.y), bf_hi(oa.y) * bf_hi(zv.y));
        y.z = cvtpk(bf_lo(ob.x) * bf_lo(zv.z), bf_hi(ob.x) * bf_hi(zv.z)); y.w = cvtpk(bf_lo(ob.y) * bf_lo(zv.w), bf_hi(ob.y) * bf_hi(zv.w));
        *(v4u*)(YMIX + row * NMIX + YC_XA + h * 128 + cx * 8) = y; } }
    __syncthreads();
}

constexpr int SS_QT = 0, SS_K = 8192, SS_V = 16384, SS_KWT = 24576, SS_QC = 32768;
DI void smlstm_unit(LAS unsigned char* lds, int bh, const bf16* PROJ, const float* GATES, const float* C0, const float* n0, const float* m0p, const float* g_head, bf16* YMIX,
                    float* outC, float* outN, float* outM, int tid) {
    const int lane = tid & 63, w = __builtin_amdgcn_readfirstlane(tid >> 6);
    const int b = bh >> 2, h = bh & 3;
    const size_t rowb = (size_t)MP + (size_t)b * 8;
    f32x4 q4, k4;
    { const bf16* p = PROJ + (rowb + w) * NPROJ + h * 256 + 4 * lane;
      const u32x2 qv = *(const u32x2*)(p + PC_Q), kv = *(const u32x2*)(p + PC_K), vv = *(const u32x2*)(p + PC_V);
      q4 = (f32x4){bf_lo(qv.x), bf_hi(qv.x), bf_lo(qv.y), bf_hi(qv.y)}; k4 = (f32x4){bf_lo(kv.x), bf_hi(kv.x), bf_lo(kv.y), bf_hi(kv.y)};
      const f32x4 v4 = (f32x4){bf_lo(vv.x), bf_hi(vv.x), bf_lo(vv.y), bf_hi(vv.y)};
      *(LAS f32x4*)(lds + SS_K + (w * 256 + 4 * lane) * 4) = k4; *(LAS f32x4*)(lds + SS_V + (w * 256 + 4 * lane) * 4) = v4;
#pragma unroll
      for (int i = 0; i < 4; ++i) LF(SS_QT + ((4 * lane + i) * 8 + w) * 4) = q4[i];
      *(LAS f32x4*)(lds + SS_QC + (w * 256 + 4 * lane) * 4) = (f32x4){0.f, 0.f, 0.f, 0.f}; }
    const float m0 = m0p[bh];
    float F[8], a[8], g[8], wsv[8];
    { float run = 0.f, cm = 0.f;
#pragma unroll
      for (int s = 0; s < 8; ++s) { const float gi = GATES[(rowb + s) * 8 + h], gf = GATES[(rowb + s) * 8 + 4 + h]; run += gf; F[s] = run; a[s] = gi - run; cm = (s == 0) ? a[0] : fmaxf(cm, a[s]); g[s] = fmaxf(m0, cm); } }
    const float g7 = g[7], wC = __expf(m0 - g7), m_new = F[7] + g7;
#pragma unroll
    for (int s = 0; s < 8; ++s) wsv[s] = __expf(a[s] - g7);
    float st[8], winter_t, hinv_t;
    { float gt = g[0], Ft = F[0], wsw = wsv[0];
#pragma unroll
      for (int s = 1; s < 8; ++s) { gt = (w == s) ? g[s] : gt; Ft = (w == s) ? F[s] : Ft; wsw = (w == s) ? wsv[s] : wsw; }
#pragma unroll
      for (int i = 0; i < 4; ++i) LF(SS_KWT + ((4 * lane + i) * 8 + w) * 4) = k4[i] * wsw;
      __syncthreads();
      float part[8];
#pragma unroll
      for (int s = 0; s < 8; ++s) { const f32x4 ks = *(const LAS f32x4*)(lds + SS_K + (s * 256 + 4 * lane) * 4); part[s] = wave_sum((q4.x * ks.x + q4.y * ks.y) + (q4.z * ks.z + q4.w * ks.w)); }
      const f32x4 n4 = *(const f32x4*)(n0 + (size_t)bh * 256 + 4 * lane);
      const float pn = wave_sum((q4.x * n4.x + q4.y * n4.y) + (q4.z * n4.z + q4.w * n4.w));
      float rowsum = 0.f;
#pragma unroll
      for (int s = 0; s < 8; ++s) { const float dcy = (s <= w) ? __expf(a[s] - gt) : 0.f; st[s] = part[s] * dcy; rowsum += st[s]; }
      winter_t = __expf(m0 - gt);
      const float den = winter_t * pn + rowsum;
      hinv_t = 1.f / fmaxf(fabsf(den), __expf(-(Ft + gt)));
    }
    f32x4 v4[8];
#pragma unroll
    for (int s = 0; s < 8; ++s) v4[s] = *(const LAS f32x4*)(lds + SS_V + (s * 256 + 4 * lane) * 4);
    f32x4 acc[8];
#pragma unroll
    for (int t = 0; t < 8; ++t) acc[t] = (f32x4){0.f, 0.f, 0.f, 0.f};
    const float* Cp = C0 + (size_t)bh * 65536 + 4 * lane; float* Co = outC + (size_t)bh * 65536 + 4 * lane;
#pragma unroll 1
    for (int rb = 0; rb < 32; rb += 16) {
      f32x4 cbuf[16];
#pragma unroll
      for (int r = 0; r < 16; ++r) cbuf[r] = __builtin_nontemporal_load((const f32x4*)(Cp + (size_t)(w + 8 * (rb + r)) * 256));
#pragma unroll
      for (int rr = 0; rr < 16; ++rr) { const int d = w + 8 * (rb + rr);
        const f32x4 c4 = cbuf[rr];
        const f32x4 qa = *(const LAS f32x4*)(lds + SS_QT + d * 32), qb = *(const LAS f32x4*)(lds + SS_QT + d * 32 + 16);
        const f32x4 ka = *(const LAS f32x4*)(lds + SS_KWT + d * 32), kb = *(const LAS f32x4*)(lds + SS_KWT + d * 32 + 16);
        acc[0] += qa.x * c4; acc[1] += qa.y * c4; acc[2] += qa.z * c4; acc[3] += qa.w * c4; acc[4] += qb.x * c4; acc[5] += qb.y * c4; acc[6] += qb.z * c4; acc[7] += qb.w * c4;
        f32x4 cn = c4 * wC;
        cn += ka.x * v4[0]; cn += ka.y * v4[1]; cn += ka.z * v4[2]; cn += ka.w * v4[3]; cn += kb.x * v4[4]; cn += kb.y * v4[5]; cn += kb.z * v4[6]; cn += kb.w * v4[7];
        __builtin_nontemporal_store(cn, (f32x4*)(Co + (size_t)d * 256)); } }
#pragma unroll
    for (int t = 0; t < 8; ++t)
#pragma unroll
        for (int i = 0; i < 4; ++i) __hip_atomic_fetch_add((LAS float*)(lds + SS_QC + (t * 256 + 4 * lane + i) * 4), acc[t][i], __ATOMIC_RELAXED, __HIP_MEMORY_SCOPE_WORKGROUP);
    if (tid < 256) { const int d = tid; const f32x4 ka = *(const LAS f32x4*)(lds + SS_KWT + d * 32), kb = *(const LAS f32x4*)(lds + SS_KWT + d * 32 + 16);
        outN[(size_t)bh * 256 + d] = wC * n0[(size_t)bh * 256 + d] + ((ka.x + ka.y) + (ka.z + ka.w)) + ((kb.x + kb.y) + (kb.z + kb.w)); }
    if (tid == 0) outM[bh] = m_new;
    __syncthreads();
    { const f32x4 qc = *(const LAS f32x4*)(lds + SS_QC + (w * 256 + 4 * lane) * 4);
      f32x4 num = qc * winter_t;
#pragma unroll
      for (int s = 0; s < 8; ++s) num += st[s] * v4[s];
      const f32x4 hv = num * hinv_t;
      const size_t row = rowb + w;
      const u32x2 ov = *(const u32x2*)(PROJ + row * NPROJ + PC_O + h * 256 + 4 * lane), zv = *(const u32x2*)(PROJ + row * NPROJ + PC_Z + h * 256 + 4 * lane);
      const f32x4 ho = (f32x4){bf_lo(ov.x) * hv.x, bf_hi(ov.x) * hv.y, bf_lo(ov.y) * hv.z, bf_hi(ov.y) * hv.w};
      const float ssq = wave_sum((ho.x * ho.x + ho.y * ho.y) + (ho.z * ho.z + ho.w * ho.w));
      const float rr = rsqrtf(ssq * (1.f / 256.f) + EPS);
      u32x2 o; o.x = cvtpk(ho.x * rr * bf_lo(zv.x), ho.y * rr * bf_hi(zv.x)); o.y = cvtpk(ho.z * rr * bf_lo(zv.y), ho.w * rr * bf_hi(zv.y));
      *(u32x2*)(YMIX + row * NMIX + YC_ML + h * 256 + 4 * lane) = o; }
    __syncthreads();
}

constexpr int SA_Q = 0, SA_S = 4096, SA_K = 16384, SA_PART = 86016;
DI void sattn_unit(LAS unsigned char* lds, int bh, const bf16* PROJ, const float* ck, const float* cv, bf16* YMIX, int tid) {
    const int lane = tid & 63, w = __builtin_amdgcn_readfirstlane(tid >> 6);
    const int b = bh >> 2, h = bh & 3;
    const size_t rowb = (size_t)MP + (size_t)b * 8;
    if (tid < 256) { const int t = tid >> 5, d = (tid & 31) * 4; const u32x2 qv = *(const u32x2*)(PROJ + (rowb + t) * NPROJ + PC_QX + h * 128 + d);
        *(LAS f32x4*)(lds + SA_Q + (t * 128 + d) * 4) = (f32x4){bf_lo(qv.x), bf_hi(qv.x), bf_lo(qv.y), bf_hi(qv.y)}; }
#pragma unroll 1
    for (int half = 0; half < 2; ++half) {
#pragma unroll
        for (int i = 0; i < 8; ++i) { const int idx = tid + 512 * i; const int key = idx >> 5, c4 = idx & 31;
            const f32x4 v = __builtin_nontemporal_load((const f32x4*)(ck + ((size_t)(b * 256 + half * 128 + key) * 4 + h) * 128 + c4 * 4)); *(LAS f32x4*)(lds + SA_K + key * 528 + c4 * 16) = v; }
        __syncthreads();
        { const int key = tid & 127, tg = tid >> 7; float a0 = 0.f, a1 = 0.f;
#pragma unroll 8
          for (int c4 = 0; c4 < 32; ++c4) { const f32x4 kx = *(const LAS f32x4*)(lds + SA_K + key * 528 + c4 * 16);
              const f32x4 qa = *(const LAS f32x4*)(lds + SA_Q + ((2 * tg) * 128 + 4 * c4) * 4), qb = *(const LAS f32x4*)(lds + SA_Q + ((2 * tg + 1) * 128 + 4 * c4) * 4);
              a0 += (kx.x * qa.x + kx.y * qa.y) + (kx.z * qa.z + kx.w * qa.w); a1 += (kx.x * qb.x + kx.y * qb.y) + (kx.z * qb.z + kx.w * qb.w); }
          LF(SA_S + ((2 * tg) * 256 + half * 128 + key) * 4) = a0 * 0.08838834764831845f; LF(SA_S + ((2 * tg + 1) * 256 + half * 128 + key) * 4) = a1 * 0.08838834764831845f; }
        __syncthreads();
    }
    { f32x4 s4 = *(const LAS f32x4*)(lds + SA_S + (w * 256 + 4 * lane) * 4);
      const float mx = wave_max(fmaxf(fmaxf(s4.x, s4.y), fmaxf(s4.z, s4.w)));
      s4.x = __expf(s4.x - mx); s4.y = __expf(s4.y - mx); s4.z = __expf(s4.z - mx); s4.w = __expf(s4.w - mx);
      const float inv = 1.f / wave_sum((s4.x + s4.y) + (s4.z + s4.w));
      *(LAS f32x4*)(lds + SA_S + (w * 256 + 4 * lane) * 4) = s4 * inv; }
    __syncthreads();
    { const int d4 = (tid & 31) * 4, kg = tid >> 5;
      f32x4 acc[8];
#pragma unroll
      for (int t = 0; t < 8; ++t) acc[t] = (f32x4){0.f, 0.f, 0.f, 0.f};
      const float* vp = cv + ((size_t)(b * 256 + kg * 16) * 4 + h) * 128 + d4;
      f32x4 vb[16];
#pragma unroll
      for (int kk = 0; kk < 16; ++kk) vb[kk] = __builtin_nontemporal_load((const f32x4*)(vp + (size_t)kk * 512));
#pragma unroll
      for (int kk = 0; kk < 16; ++kk) { const int key = kg * 16 + kk;
#pragma unroll
          for (int t = 0; t < 8; ++t) acc[t] += LF(SA_S + (t * 256 + key) * 4) * vb[kk]; }
#pragma unroll
      for (int t = 0; t < 8; ++t) *(LAS f32x4*)(lds + SA_K + ((kg * 8 + t) * 128 + d4) * 4) = acc[t]; }
    __syncthreads();
    { const int t = tid >> 6, d = (tid & 63) * 2; float o0 = 0.f, o1 = 0.f;
#pragma unroll
      for (int kg = 0; kg < 16; ++kg) { const f32x2v p = *(const LAS f32x2v*)(lds + SA_K + ((kg * 8 + t) * 128 + d) * 4); o0 += p.x; o1 += p.y; }
      const size_t row = rowb + t; const unsigned zv = *(const unsigned*)(PROJ + row * NPROJ + PC_ZX + h * 128 + d);
      *(unsigned*)(YMIX + row * NMIX + YC_XA + h * 128 + d) = cvtpk(o0 * bf_lo(zv), o1 * bf_hi(zv)); }
    __syncthreads();
}

DI void conv_token(const bf16* p, const float (&w0)[8], const float (&w1)[8], const float (&w2)[8], const float (&cb)[8], float (&u2)[8], float (&u1)[8], float (&u)[8], bf16* yout) {
    const v4u bg = *(const v4u*)(p + PC_BG), cg = *(const v4u*)(p + PC_CG), xc = *(const v4u*)(p + PC_XC), zc = *(const v4u*)(p + PC_ZCV);
    float y[8];
#pragma unroll
    for (int i = 0; i < 4; ++i) {
        u[2 * i] = bf_lo(cg[i]) * bf_lo(xc[i]); u[2 * i + 1] = bf_hi(cg[i]) * bf_hi(xc[i]);
        const float yc0 = cb[2 * i] + w0[2 * i] * u2[2 * i] + w1[2 * i] * u1[2 * i] + w2[2 * i] * u[2 * i];
        const float yc1 = cb[2 * i + 1] + w0[2 * i + 1] * u2[2 * i + 1] + w1[2 * i + 1] * u1[2 * i + 1] + w2[2 * i + 1] * u[2 * i + 1];
        y[2 * i] = bf_lo(bg[i]) * yc0 * bf_lo(zc[i]); y[2 * i + 1] = bf_hi(bg[i]) * yc1 * bf_hi(zc[i]); }
    v4u o; o.x = cvtpk(y[0], y[1]); o.y = cvtpk(y[2], y[3]); o.z = cvtpk(y[4], y[5]); o.w = cvtpk(y[6], y[7]);
    *(v4u*)yout = o;
}
DI void conv_item(int item, const bf16* PROJ, const float* state_conv, const float* conv_w, const float* conv_b, bf16* YMIX, float* out_cvp, float* out_cvs, int tid) {
    const int c8 = tid & 63, sub = tid >> 6, ch = 8 * c8;
    float w0[8], w1[8], w2[8], cb[8], u2[8], u1[8], u[8];
#pragma unroll
    for (int i = 0; i < 8; ++i) { w0[i] = conv_w[ch + i]; w1[i] = conv_w[512 + ch + i]; w2[i] = conv_w[1024 + ch + i]; cb[i] = conv_b[ch + i]; }
    if (item < 128) {
        const int b = item >> 4, blk = item & 15, t0 = blk * 128 + sub * 16; const size_t rowb = (size_t)b * SEQ;
#pragma unroll
        for (int i = 0; i < 8; ++i) { u2[i] = 0.f; u1[i] = 0.f; }
        if (t0 >= 2) {
            const bf16* pa = PROJ + (rowb + t0 - 2) * NPROJ + ch; const bf16* pb = PROJ + (rowb + t0 - 1) * NPROJ + ch;
            const v4u cga = *(const v4u*)(pa + PC_CG), xca = *(const v4u*)(pa + PC_XC), cgb = *(const v4u*)(pb + PC_CG), xcb = *(const v4u*)(pb + PC_XC);
#pragma unroll
            for (int i = 0; i < 4; ++i) { u2[2 * i] = bf_lo(cga[i]) * bf_lo(xca[i]); u2[2 * i + 1] = bf_hi(cga[i]) * bf_hi(xca[i]); u1[2 * i] = bf_lo(cgb[i]) * bf_lo(xcb[i]); u1[2 * i + 1] = bf_hi(cgb[i]) * bf_hi(xcb[i]); }
        }
#pragma unroll 2
        for (int tt = 0; tt < 16; ++tt) { const int t = t0 + tt; const size_t row = rowb + t;
            conv_token(PROJ + row * NPROJ + ch, w0, w1, w2, cb, u2, u1, u, YMIX + row * NMIX + YC_CV + ch);
            if (t >= SEQ - 2) { float* o = out_cvp + ((size_t)b * 2 + (t - (SEQ - 2))) * 512 + ch; *(f32x4*)o = (f32x4){u[0], u[1], u[2], u[3]}; *(f32x4*)(o + 4) = (f32x4){u[4], u[5], u[6], u[7]}; }
#pragma unroll
            for (int i = 0; i < 8; ++i) { u2[i] = u1[i]; u1[i] = u[i]; } }
    } else {
        const int si = item - 128;
#pragma unroll 1
        for (int q = 0; q < 4; ++q) { const int seq = si * 32 + sub * 4 + q; const size_t rowb = (size_t)MP + (size_t)seq * 8;
#pragma unroll
            for (int i = 0; i < 8; ++i) { u2[i] = state_conv[((size_t)seq * 2 + 0) * 512 + ch + i]; u1[i] = state_conv[((size_t)seq * 2 + 1) * 512 + ch + i]; }
#pragma unroll 2
            for (int t = 0; t < 8; ++t) { const size_t row = rowb + t;
                conv_token(PROJ + row * NPROJ + ch, w0, w1, w2, cb, u2, u1, u, YMIX + row * NMIX + YC_CV + ch);
                if (t >= 6) { float* o = out_cvs + ((size_t)seq * 2 + (t - 6)) * 512 + ch; *(f32x4*)o = (f32x4){u[0], u[1], u[2], u[3]}; *(f32x4*)(o + 4) = (f32x4){u[4], u[5], u[6], u[7]}; }
#pragma unroll
                for (int i = 0; i < 8; ++i) { u2[i] = u1[i]; u1[i] = u[i]; } } }
    }
}
constexpr int IT_SM = 0, IT_SA = 512, IT_SC = 1024, IT_PA = 1028, IT_PC = 1284, NITEMS = 1412;

#ifndef PH_MASK
#define PH_MASK 511
#endif
#ifndef PROBE_REPEAT
#define PROBE_REPEAT -1
#endif
#ifndef PROBE_QSEL
#define PROBE_QSEL 1
#endif
constexpr int N_PHASES = 6;
struct Args { const float* in[19]; float* out; unsigned char* ws; int ph_lo, ph_hi, li, qsel; };
__global__ void __launch_bounds__(512, 2) hyb_fwd(Args args) {
    extern __shared__ __attribute__((aligned(16))) unsigned char lds_raw[];
    LAS unsigned char* lds = (LAS unsigned char*)lds_raw;
    volatile LAS unsigned* MISC = (volatile LAS unsigned*)(lds + MISC_OFF);
    const int tid = threadIdx.x, lane = tid & 63, wave = __builtin_amdgcn_readfirstlane(tid >> 6);
    const int bid = blockIdx.x, G = gridDim.x;
    unsigned char* const ws = args.ws;
    gu32* const ctl = (gu32*)(ws + WS_CTL);
#define xp ((const float*)args.in[0])
#define xs ((const float*)args.in[1])
#define st_C ((const float*)args.in[2])
#define st_n ((const float*)args.in[3])
#define st_m ((const float*)args.in[4])
#define st_conv ((const float*)args.in[5])
#define ck ((const float*)args.in[6])
#define cv ((const float*)args.in[7])
#define memp ((const float*)args.in[8])
#define g_norm ((const float*)args.in[9])
#define w_in ((const float*)args.in[10])
#define b_if ((const float*)args.in[11])
#define g_head ((const float*)args.in[12])
#define conv_w ((const float*)args.in[13])
#define conv_b ((const float*)args.in[14])
#define g_mem ((const float*)args.in[15])
#define w_kv ((const float*)args.in[16])
#define w_out ((const float*)args.in[17])
#define g_final ((const float*)args.in[18])
#define out (args.out)
#define Wt_in ((bf16*)(ws + WS_WIN))
#define Wt_out ((bf16*)(ws + WS_WOUT))
#define Wt_kv ((bf16*)(ws + WS_WKV))
#define MEMN ((bf16*)(ws + WS_MEMN))
#define KMEM ((bf16*)(ws + WS_KMEM))
#define VT ((bf16*)(ws + WS_VT))
#define GATES ((float*)(ws + WS_GATES))
#define XN ((bf16*)(ws + WS_XN))
#define YMIX ((bf16*)(ws + WS_YMIX))
#define PROJ ((bf16*)(ws + WS_PROJ))
    if (tid < 64) MISC[tid] = 0u;
    __syncthreads();
    XcdBarrier bar = xcd_barrier_post((unsigned*)(ctl + CW_BAR) + args.li * XCD_BAR_WORDS, MISC + 8);
    const int lo = args.ph_lo, hi = args.ph_hi;
#define IN(k) (lo <= (k) && (k) < hi)
#define BOTH(k) (IN(k) && IN((k) + 1))
    const int gw = bid * 8 + wave, NGW = G * 8;

    if ((PH_MASK & 1) && IN(0)) {
        LAS float* scr = (LAS float*)(lds + wave * 16384);
        constexpr int I_IN = 16 * 256, I_OUT = 32 * 32, I_KV = 16 * 32, NIT = I_IN + I_OUT + I_KV;
        for (int it = gw; it < NIT; it += NGW) {
            int r = it;
            if (r < I_IN) { const int kb = r >> 8, nb = r & 255, dstrow = 32 * nb; const int srccol = dstrow + (dstrow >= 5120 ? 8 : 0); const float sc = (dstrow >= 1024 && dstrow < 2048) ? 0.0625f : 1.f;
                p0_transpose_item(w_in, INCOLS, srccol, 64 * kb, Wt_in, 1024, dstrow, sc, scr, lane); continue; }
            r -= I_IN;
            if (r < I_OUT) { const int kb = r >> 5, nb = r & 31; p0_transpose_item(w_out, 1024, 32 * nb, 64 * kb, Wt_out, 2048, 32 * nb, 1.f, scr, lane); continue; }
            r -= I_OUT;
            { const int kb = r >> 5, nb = r & 31; p0_transpose_item(w_kv, 1024, 32 * nb, 64 * kb, Wt_kv, 1024, 32 * nb, 1.f, scr, lane); }
        }
        __syncthreads();
        LAS float* gwl = (LAS float*)lds;
        for (int e = tid; e < 8192; e += 512) { const int q = e >> 10, k = e & 1023; gwl[e] = g_norm[k] * w_in[(size_t)k * INCOLS + 5120 + q]; }
        __syncthreads();
        for (int m = gw; m < MT; m += NGW) { const float* xrow = (m < MP) ? xp + (size_t)m * DM : xs + (size_t)(m - MP) * DM; xn_row(xrow, g_norm, XN + (size_t)m * DM, GATES + (size_t)m * 8, gwl, b_if, lane); }
        for (int m = gw; m < MMEM; m += NGW) xn_row(memp + (size_t)m * DM, g_mem, MEMN + (size_t)m * DM, nullptr, gwl, b_if, lane);
        if (BOTH(0)) xcd_barrier(bar);
    }
    if ((PH_MASK & 2) && IN(1)) {
        { pg8::Gemm g{XN, Wt_in, MT, NPROJ, DM, DM}; pg8::StaticOrder S; S.init(MT, NPROJ, G, bid); pg8::EpiBf16Plain E{PROJ, NPROJ, 1, g_head};
          pg8::gemm_phase<pg8::EpiBf16Plain, pg8::StaticOrder, true, true>(lds, g, S, E); }
        if (bid >= 128 && bid < 160) { pg8::Gemm g{MEMN, Wt_kv, MMEM, 1024, DM, DM}; pg8::StaticOrder S; S.init(MMEM, 1024, 32, bid - 128); pg8::EpiKV E{out + O_MK, out + O_MV, KMEM};
          pg8::gemm_phase<pg8::EpiKV, pg8::StaticOrder, true, true>(lds, g, S, E); }
        if (bid >= 160 && bid < 176) { pg8::Gemm g{Wt_kv + (size_t)512 * DM, MEMN, 512, MMEM, DM, DM}; pg8::StaticOrder S; S.init(512, MMEM, 16, bid - 160); pg8::EpiBf16Plain E{VT, MMEM, 0, nullptr};
          pg8::gemm_phase<pg8::EpiBf16Plain, pg8::StaticOrder, true, true>(lds, g, S, E); }
        if (BOTH(1)) xcd_barrier(bar);
    }
    if (IN(2)) {
        __syncthreads();
        if ((PH_MASK & 4) && args.qsel != 3 && bid < 128) scan_job(lds, 4 * (bid & 7) + (bid >> 5), (bid >> 3) & 3, PROJ, GATES, YMIX, (float*)(ws + WS_SSQ), out + O_CP, out + O_NP, out + O_MP, tid);
        for (; args.qsel != 2;) {
            if (tid == 0) MISC[4] = __hip_atomic_fetch_add(ctl + CW_QHEAD + 64 * (args.qsel & 1), 1u, RLX_AGENT);
            __syncthreads();
            const int it = (int)MISC[4];
            __syncthreads();
            if (it >= NITEMS) break;
            int tid = threadIdx.x; OPAQUE(tid);
            if (it < IT_SA) { if (PH_MASK & 8) smlstm_unit(lds, it - IT_SM, PROJ, GATES, st_C, st_n, st_m, g_head, YMIX, out + O_CS, out + O_NS, out + O_MS, tid); }
            else if (it < IT_SC) { if (PH_MASK & 16) sattn_unit(lds, it - IT_SA, PROJ, ck, cv, YMIX, tid); }
            else if (it < IT_PA) { if (PH_MASK & 32) conv_item(128 + (it - IT_SC), PROJ, st_conv, conv_w, conv_b, YMIX, out + O_CVP, out + O_CVS, tid); }
            else if (it < IT_PC) { if (PH_MASK & 64) attn_prompt_unit(lds, it - IT_PA, PROJ, KMEM, VT, YMIX, tid); }
            else { if (PH_MASK & 32) conv_item(it - IT_PC, PROJ, st_conv, conv_w, conv_b, YMIX, out + O_CVP, out + O_CVS, tid); }
        }
        if (BOTH(2)) xcd_barrier(bar);
    }
    if (IN(3)) {
        const float* SSQ = (const float*)(ws + WS_SSQ);
        for (int u = gw; u < MP * 4; u += NGW) { const float part = (lane < 16) ? SSQ[(size_t)u * 16 + lane] : 0.f;
            const float rr = rsqrtf(wave_sum(part) * (1.f / 256.f) + EPS);
            u32x2* yp = (u32x2*)(YMIX + (size_t)(u >> 2) * NMIX + YC_ML + (u & 3) * 256) + lane; const u32x2 v = *yp;
            u32x2 o; o.x = cvtpk(bf_lo(v.x) * rr, bf_hi(v.x) * rr); o.y = cvtpk(bf_lo(v.y) * rr, bf_hi(v.y) * rr); *yp = o; }
        if (BOTH(3)) xcd_barrier(bar);
    }
    if ((PH_MASK & 128) && IN(4)) {
        __syncthreads();
        { pg8::Gemm g{YMIX, Wt_out, MP, DM, NMIX, NMIX}; pg8::StaticOrder S; S.init(MP, DM, G, bid); pg8::EpiOut E{xp, xs, MP, out + O_YP};
          pg8::gemm_phase<pg8::EpiOut, pg8::StaticOrder, true, true>(lds, g, S, E); }
        if (bid < 64) { const int sp = bid >> 4;
          pg8::Gemm g{YMIX + (size_t)MP * NMIX + sp * 512, Wt_out + sp * 512, MS, DM, 512, NMIX}; pg8::StaticOrder S; S.init(MS, DM, 16, bid & 15);
          pg8::EpiSlab E{(float*)(ws + WS_SLAB) + (size_t)sp * MS * DM};
          pg8::gemm_phase<pg8::EpiSlab, pg8::StaticOrder, true, true>(lds, g, S, E); }
        if (BOTH(4)) xcd_barrier(bar);
    }
    if ((PH_MASK & 256) && IN(5)) {
        for (int m = gw; m < MT; m += NGW) { f32x4* row = (f32x4*)(out + O_YP + (size_t)m * DM) + lane; f32x4 v[4]; float s = 0.f;
#pragma unroll
            for (int j = 0; j < 4; ++j) {
                if (m < MP) v[j] = row[64 * j];
                else { const size_t o = (size_t)(m - MP) * DM / 4 + 64 * j + lane; const f32x4* sl = (const f32x4*)(ws + WS_SLAB);
                    v[j] = ((const f32x4*)xs)[o] + ((sl[o] + sl[o + (size_t)MS * DM / 4]) + (sl[o + (size_t)2 * MS * DM / 4] + sl[o + (size_t)3 * MS * DM / 4])); }
                s += (v[j].x * v[j].x + v[j].y * v[j].y) + (v[j].z * v[j].z + v[j].w * v[j].w); }
            const float r = rsqrtf(wave_sum(s) * (1.f / 1024.f) + EPS);
#pragma unroll
            for (int j = 0; j < 4; ++j) { const f32x4 gv = ((const f32x4*)g_final)[64 * j + lane]; row[64 * j] = v[j] * r * gv; } }
    }
#undef IN
#undef BOTH
}
#undef xp
#undef xs
#undef st_C
#undef st_n
#undef st_m
#undef st_conv
#undef ck
#undef cv
#undef memp
#undef g_norm
#undef w_in
#undef b_if
#undef g_head
#undef conv_w
#undef conv_b
#undef g_mem
#undef w_kv
#undef w_out
#undef g_final
#undef out
#undef Wt_in
#undef Wt_out
#undef Wt_kv
#undef MEMN
#undef KMEM
#undef VT
#undef GATES
#undef XN
#undef YMIX
#undef PROJ

extern "C" void kernel_launch(void* const* d_in, const int* in_sizes, int n_in, void* d_out, int out_size, void* d_ws, size_t ws_size, hipStream_t stream) {
    static int grid = 0;
    if (grid == 0) {
        if (n_in != 19 || (size_t)out_size != O_END || ws_size < WS_END) { fprintf(stderr, "kernel_launch: unexpected shapes (n_in %d, out %d, ws %zu); nothing launched\n", n_in, out_size, ws_size); grid = -1; return; }
        int dev = 0, cus = 0;
        if (hipGetDevice(&dev) != hipSuccess || hipDeviceGetAttribute(&cus, hipDeviceAttributeMultiprocessorCount, dev) != hipSuccess) { grid = -1; return; }
        if (hipFuncSetAttribute((const void*)hyb_fwd, hipFuncAttributeMaxDynamicSharedMemorySize, LDS_BYTES) != hipSuccess) { fprintf(stderr, "kernel_launch: hipFuncSetAttribute failed\n"); grid = -1; return; }
        (void)hipGetLastError();
        grid = cus;
        if (grid != 256) fprintf(stderr, "kernel_launch: %d CUs; this build's phase maps assume 256\n", grid);
    }
    if (grid < 0) return;
    if (hipMemsetAsync((char*)d_ws + WS_CTL, 0, CTL_ZERO_BYTES, stream) != hipSuccess) return;
    Args a{};
    for (int i = 0; i < 19; ++i) a.in[i] = (const float*)d_in[i];
    a.out = (float*)d_out; a.ws = (unsigned char*)d_ws;
    if (PROBE_REPEAT < 0) { a.ph_lo = 0; a.ph_hi = N_PHASES; hipLaunchKernelGGL(hyb_fwd, dim3(grid), dim3(512), LDS_BYTES, stream, a); }
    else {
        a.ph_lo = 0; a.ph_hi = PROBE_REPEAT + 1; a.li = 0; a.qsel = 0; hipLaunchKernelGGL(hyb_fwd, dim3(grid), dim3(512), LDS_BYTES, stream, a);
        a.ph_lo = PROBE_REPEAT; a.ph_hi = PROBE_REPEAT + 1; a.li = 1; a.qsel = PROBE_QSEL; hipLaunchKernelGGL(hyb_fwd, dim3(grid), dim3(512), LDS_BYTES, stream, a);
        if (PROBE_REPEAT + 1 < N_PHASES) { a.ph_lo = PROBE_REPEAT + 1; a.ph_hi = N_PHASES; a.li = 2; a.qsel = 0; hipLaunchKernelGGL(hyb_fwd, dim3(grid), dim3(512), LDS_BYTES, stream, a); }
    }
}
```
